# Optimizing an MI355X kernel written in HIP

```python
import jax
import jax.numpy as jnp
from jax import lax
import numpy as np

D_MODEL = 1024
BATCH = 2
SEQ = 8192
DEPTH = 2

GRID_W = 64
CTX_LEN = 256
HEAD_DIM = 64
A_Q_HEADS = 12
A_KV_HEADS = 4
B_GROUPS = 4
B_GROUP_DIM = 64
C_CHANNELS = 512
C_KERNEL = 31
D_HEADS = 8
NA_WIN_ROWS = 8
NA_WIN_COLS = 16
D_FF = 2816
ROPE_THETA = 10000.0
Q_BLOCK = 128
NORM_EPS = 1e-6
N_MOD = 9
FFN_RES_WEIGHT = 0.5

A_Q_W = A_Q_HEADS * HEAD_DIM
A_KV_W = A_KV_HEADS * HEAD_DIM
B_W = B_GROUPS * B_GROUP_DIM
AB_IN = A_Q_W + 2 * A_KV_W + B_W
AB_OUT = A_Q_W + B_W
D_W = D_HEADS * HEAD_DIM
CD_IN = 2 * C_CHANNELS + 3 * D_W
CD_OUT = C_CHANNELS + D_W

kernel_name = 'hybrid_diffusion_gqa_fourier_conformer_natten'


def _rmsnorm(x):
    xf = x.astype(jnp.float32)
    return (xf * lax.rsqrt(jnp.mean(xf * xf, axis=-1, keepdims=True) + NORM_EPS)).astype(x.dtype)


def _layernorm(x, w, b):
    xf = x.astype(jnp.float32)
    mu = jnp.mean(xf, axis=-1, keepdims=True)
    var = jnp.mean(jnp.square(xf - mu), axis=-1, keepdims=True)
    return ((xf - mu) * lax.rsqrt(var + NORM_EPS)).astype(x.dtype) * w + b


def _modulate(x, shift, scale):
    return _rmsnorm(x) * (1 + scale) + shift


def _swiglu(h, w_gate, w_up, w_down):
    return (jax.nn.silu(h @ w_gate) * (h @ w_up)) @ w_down


def _macaron_half(x, shift, scale, gate, w_gate, w_up, w_down):
    return x + FFN_RES_WEIGHT * gate * _swiglu(_modulate(x, shift, scale), w_gate, w_up, w_down)


def _rope_2d(x, pos_row, pos_col):
    half = x.shape[-1] // 2
    n_ax = half // 2
    inv = ROPE_THETA ** (-jnp.arange(n_ax, dtype=jnp.float32) / n_ax)
    ang = jnp.concatenate([pos_row[:, None] * inv, pos_col[:, None] * inv], axis=-1)
    cos = jnp.cos(ang)[None, :, None, :].astype(x.dtype)
    sin = jnp.sin(ang)[None, :, None, :].astype(x.dtype)
    x1, x2 = x[..., :half], x[..., half:]
    return jnp.concatenate([x1 * cos - x2 * sin, x2 * cos + x1 * sin], axis=-1)


def _attend(q, k, v):
    bsz, lq, heads, hd = q.shape
    kvh = k.shape[2]
    qg = q.reshape(bsz, lq, kvh, heads // kvh, hd)
    s = jnp.einsum('bqkgd,blkd->bkgql', qg, k).astype(jnp.float32) * (hd ** -0.5)
    p = jax.nn.softmax(s, axis=-1).astype(v.dtype)
    o = jnp.einsum('bkgql,blkd->bqkgd', p, v)
    return o.reshape(bsz, lq, heads * hd)


def _gqa_blocks(q, k_all, v_all):
    bsz, seq, heads, hd = q.shape
    qb = jnp.moveaxis(q.reshape(bsz, seq // Q_BLOCK, Q_BLOCK, heads, hd), 1, 0)
    out = lax.map(lambda qblk: _attend(qblk, k_all, v_all), qb)
    return jnp.moveaxis(out, 0, 1).reshape(bsz, seq, heads * hd)


def _fourier(h):
    bsz, length, _ = h.shape
    hg = h.reshape(bsz, length, B_GROUPS, B_GROUP_DIM).astype(jnp.float32)
    f = jnp.fft.fft2(hg, axes=(1, 3), norm='ortho').real
    return f.reshape(bsz, length, B_W).astype(h.dtype)


def _conv_module(a, g, dw_w, dw_b, ln_w, ln_b):
    u = a * jax.nn.sigmoid(g)
    y = lax.conv_general_dilated(u, dw_w[:, None, :], window_strides=(1,),
                                 padding=[(C_KERNEL // 2, C_KERNEL // 2)],
                                 dimension_numbers=('NWC', 'WIO', 'NWC'),
                                 feature_group_count=u.shape[-1]) + dw_b
    return jax.nn.silu(_layernorm(y, ln_w, ln_b))


def _neighbourhood_attention(q, k, v, kc, vc, rpb):
    bsz, seq, heads, hd = q.shape
    rows = seq // GRID_W
    wr = min(NA_WIN_ROWS, rows)
    wc = NA_WIN_COLS
    qg = q.reshape(bsz, rows, GRID_W, heads, hd)
    kg = k.reshape(bsz, rows, GRID_W, heads, hd)
    vg = v.reshape(bsz, rows, GRID_W, heads, hd)
    col_q = jnp.arange(GRID_W)
    col_idx = jnp.clip(col_q - wc // 2, 0, GRID_W - wc)[:, None] + jnp.arange(wc)[None, :]
    col_off = col_idx - col_q[:, None] + (NA_WIN_COLS - 1)
    scale = hd ** -0.5

    def row_block(r):
        start = jnp.clip(r - wr // 2, 0, rows - wr)
        qr = lax.dynamic_index_in_dim(qg, r, axis=1, keepdims=False)
        kn = lax.dynamic_slice_in_dim(kg, start, wr, axis=1)[:, :, col_idx]
        vn = lax.dynamic_slice_in_dim(vg, start, wr, axis=1)[:, :, col_idx]
        row_off = start + jnp.arange(wr) - r + (NA_WIN_ROWS - 1)
        bias = rpb[:, row_off[None, :, None], col_off[:, None, :]]
        s_nb = (jnp.einsum('bqhd,brqjhd->bhqrj', qr, kn).astype(jnp.float32) * scale
                + bias[None].astype(jnp.float32)).reshape(bsz, heads, GRID_W, wr * wc)
        s_cx = jnp.einsum('bqhd,blhd->bhql', qr, kc).astype(jnp.float32) * scale
        p = jax.nn.softmax(jnp.concatenate([s_nb, s_cx], axis=-1), axis=-1).astype(v.dtype)
        p_nb = p[..., :wr * wc].reshape(bsz, heads, GRID_W, wr, wc)
        p_cx = p[..., wr * wc:]
        return (jnp.einsum('bhqrj,brqjhd->bqhd', p_nb, vn)
                + jnp.einsum('bhql,blhd->bqhd', p_cx, vc))

    out = lax.map(row_block, jnp.arange(rows))
    return jnp.moveaxis(out, 0, 1).reshape(bsz, seq, heads * hd)


def _mixer_ab(hl, hc, w_in, w_out, q_norm, k_norm, with_ctx):
    bsz, seq, _ = hl.shape
    lc = hc.shape[1]
    t = jnp.arange(seq)
    row = (t // GRID_W).astype(jnp.float32)
    col = (t % GRID_W).astype(jnp.float32)
    cuts = [A_Q_W, A_Q_W + A_KV_W, A_Q_W + 2 * A_KV_W]
    q, k, v, f = jnp.split(hl @ w_in, cuts, axis=-1)
    q = _rope_2d(_rmsnorm(q.reshape(bsz, seq, A_Q_HEADS, HEAD_DIM)) * q_norm, row, col)
    k = _rope_2d(_rmsnorm(k.reshape(bsz, seq, A_KV_HEADS, HEAD_DIM)) * k_norm, row, col)
    v = v.reshape(bsz, seq, A_KV_HEADS, HEAD_DIM)
    if with_ctx:
        qc, kc, vc, fc = jnp.split(hc @ w_in, cuts, axis=-1)
    else:
        kc, vc = jnp.split(hc @ w_in[:, A_Q_W:A_Q_W + 2 * A_KV_W], [A_KV_W], axis=-1)
    kc = _rmsnorm(kc.reshape(bsz, lc, A_KV_HEADS, HEAD_DIM)) * k_norm
    vc = vc.reshape(bsz, lc, A_KV_HEADS, HEAD_DIM)
    k_all = jnp.concatenate([kc, k], axis=1)
    v_all = jnp.concatenate([vc, v], axis=1)
    yl = jnp.concatenate([_gqa_blocks(q, k_all, v_all), _fourier(f)], axis=-1) @ w_out
    if not with_ctx:
        return yl, None
    qc = _rmsnorm(qc.reshape(bsz, lc, A_Q_HEADS, HEAD_DIM)) * q_norm
    yc = jnp.concatenate([_attend(qc, kc, vc), _fourier(fc)], axis=-1) @ w_out
    return yl, yc


def _mixer_cd(hl, hc, w_in, w_out, dw_w, dw_b, ln_w, ln_b, rpb, with_ctx):
    bsz, seq, _ = hl.shape
    lc = hc.shape[1]
    cuts = [C_CHANNELS, 2 * C_CHANNELS, 2 * C_CHANNELS + D_W, 2 * C_CHANNELS + 2 * D_W]
    ga, gb, q, k, v = jnp.split(hl @ w_in, cuts, axis=-1)
    if with_ctx:
        gac, gbc, qc, kc, vc = jnp.split(hc @ w_in, cuts, axis=-1)
    else:
        kc, vc = jnp.split(hc @ w_in[:, 2 * C_CHANNELS + D_W:], [D_W], axis=-1)
    kc = kc.reshape(bsz, lc, D_HEADS, HEAD_DIM)
    vc = vc.reshape(bsz, lc, D_HEADS, HEAD_DIM)
    y_conv = _conv_module(ga, gb, dw_w, dw_b, ln_w, ln_b)
    y_na = _neighbourhood_attention(q.reshape(bsz, seq, D_HEADS, HEAD_DIM),
                                    k.reshape(bsz, seq, D_HEADS, HEAD_DIM),
                                    v.reshape(bsz, seq, D_HEADS, HEAD_DIM), kc, vc, rpb)
    yl = jnp.concatenate([y_conv, y_na], axis=-1) @ w_out
    if not with_ctx:
        return yl, None
    yc_conv = _conv_module(gac, gbc, dw_w, dw_b, ln_w, ln_b)
    yc_att = _attend(qc.reshape(bsz, lc, D_HEADS, HEAD_DIM), kc, vc)
    yc = jnp.concatenate([yc_conv, yc_att], axis=-1) @ w_out
    return yl, yc


def setup_inputs(seed: int = 0) -> dict:
    key = jax.random.key(seed)
    ks = jax.random.split(key, 21)
    n_even = (DEPTH + 1) // 2
    n_odd = DEPTH // 2

    def nrm(k, shape, scale):
        return jax.random.normal(k, shape, jnp.float32) * scale

    return {
        'x': nrm(ks[0], (BATCH, SEQ, D_MODEL), 1.0),
        'c': nrm(ks[1], (BATCH, D_MODEL), 1.0),
        'ctx': nrm(ks[2], (BATCH, CTX_LEN, D_MODEL), 1.0),
        'c_ctx': nrm(ks[3], (D_MODEL,), 1.0),
        'w_mod': nrm(ks[4], (DEPTH, D_MODEL, N_MOD * D_MODEL), 0.5 * D_MODEL ** -0.5),
        'b_mod': nrm(ks[5], (DEPTH, N_MOD * D_MODEL), 0.02),
        'ffn_w_gate': nrm(ks[6], (DEPTH, 2, D_MODEL, D_FF), D_MODEL ** -0.5),
        'ffn_w_up': nrm(ks[7], (DEPTH, 2, D_MODEL, D_FF), D_MODEL ** -0.5),
        'ffn_w_down': nrm(ks[8], (DEPTH, 2, D_FF, D_MODEL), D_FF ** -0.5),
        'ab_w_in': nrm(ks[9], (n_even, D_MODEL, AB_IN), D_MODEL ** -0.5),
        'ab_w_out': nrm(ks[10], (n_even, AB_OUT, D_MODEL), AB_OUT ** -0.5),
        'ab_q_norm': 1.0 + nrm(ks[11], (n_even, HEAD_DIM), 0.05),
        'ab_k_norm': 1.0 + nrm(ks[12], (n_even, HEAD_DIM), 0.05),
        'cd_w_in': nrm(ks[13], (n_odd, D_MODEL, CD_IN), D_MODEL ** -0.5),
        'cd_w_out': nrm(ks[14], (n_odd, CD_OUT, D_MODEL), CD_OUT ** -0.5),
        'cd_dw_w': nrm(ks[15], (n_odd, C_KERNEL, C_CHANNELS), C_KERNEL ** -0.5),
        'cd_dw_b': nrm(ks[16], (n_odd, C_CHANNELS), 0.02),
        'cd_ln_w': 1.0 + nrm(ks[17], (n_odd, C_CHANNELS), 0.05),
        'cd_ln_b': nrm(ks[18], (n_odd, C_CHANNELS), 0.02),
        'cd_rpb': nrm(ks[19], (n_odd, D_HEADS, 2 * NA_WIN_ROWS - 1, 2 * NA_WIN_COLS - 1), 0.1),
        'final_norm': 1.0 + nrm(ks[20], (D_MODEL,), 0.05),
    }


def reference(x, c, ctx, c_ctx, w_mod, b_mod, ffn_w_gate, ffn_w_up, ffn_w_down,
              ab_w_in, ab_w_out, ab_q_norm, ab_k_norm,
              cd_w_in, cd_w_out, cd_dw_w, cd_dw_b, cd_ln_w, cd_ln_b, cd_rpb, final_norm):
    bsz = x.shape[0]
    xl, xc = x, ctx
    for layer in range(DEPTH):
        last = layer == DEPTH - 1
        ml = (jax.nn.silu(c) @ w_mod[layer] + b_mod[layer]).reshape(bsz, N_MOD, 1, D_MODEL)
        mc = (jax.nn.silu(c_ctx) @ w_mod[layer] + b_mod[layer]).reshape(N_MOD, D_MODEL)
        xl = _macaron_half(xl, ml[:, 0], ml[:, 1], ml[:, 2],
                           ffn_w_gate[layer, 0], ffn_w_up[layer, 0], ffn_w_down[layer, 0])
        xc = _macaron_half(xc, mc[0], mc[1], mc[2],
                           ffn_w_gate[layer, 0], ffn_w_up[layer, 0], ffn_w_down[layer, 0])
        hl = _modulate(xl, ml[:, 3], ml[:, 4])
        hc = _modulate(xc, mc[3], mc[4])
        i = layer // 2
        if layer % 2 == 0:
            yl, yc = _mixer_ab(hl, hc, ab_w_in[i], ab_w_out[i], ab_q_norm[i], ab_k_norm[i], not last)
        else:
            yl, yc = _mixer_cd(hl, hc, cd_w_in[i], cd_w_out[i], cd_dw_w[i], cd_dw_b[i],
                               cd_ln_w[i], cd_ln_b[i], cd_rpb[i], not last)
        xl = xl + ml[:, 5] * yl
        xl = _macaron_half(xl, ml[:, 6], ml[:, 7], ml[:, 8],
                           ffn_w_gate[layer, 1], ffn_w_up[layer, 1], ffn_w_down[layer, 1])
        if not last:
            xc = xc + mc[5] * yc
            xc = _macaron_half(xc, mc[6], mc[7], mc[8],
                               ffn_w_gate[layer, 1], ffn_w_up[layer, 1], ffn_w_down[layer, 1])
    return _rmsnorm(xl) * final_norm
```

```cpp
#include <hip/hip_runtime.h>
#include <hip/hip_cooperative_groups.h>
#include <cstdio>
namespace cg = cooperative_groups;

#ifndef MK_MULTI
#define MK_MULTI 0
#endif

#define LAS __attribute__((address_space(3)))
typedef unsigned short bf16_t;
typedef short bf16x8 __attribute__((ext_vector_type(8)));
typedef float f32x4 __attribute__((ext_vector_type(4)));
typedef float f32x2 __attribute__((ext_vector_type(2)));
typedef float f32x16 __attribute__((ext_vector_type(16)));
typedef unsigned u32x4 __attribute__((ext_vector_type(4)));
typedef unsigned u32x2 __attribute__((ext_vector_type(2)));

constexpr int TL = 16384, TCX = 512, TT = 16896, DM = 1024, DFF = 2816;
constexpr int SEQ = 8192, CTXL = 256, NKEY = 8448;
constexpr float LOG2E = 1.4426950408889634f;
constexpr float QSCALE = 0.125f * LOG2E;
constexpr int LDS_BYTES = 131072 + 16;

constexpr size_t SZ_W1T = (size_t)5632 * 1024 * 2, SZ_W2T = (size_t)1024 * 2816 * 2;
constexpr size_t OFF_W1T = 0;
constexpr size_t OFF_W2T = OFF_W1T + 4 * SZ_W1T;
constexpr size_t OFF_ABIN = OFF_W2T + 4 * SZ_W2T;
constexpr size_t OFF_ABOUT = OFF_ABIN + (size_t)1792 * 1024 * 2;
constexpr size_t OFF_CDIN = OFF_ABOUT + (size_t)1024 * 1024 * 2;
constexpr size_t OFF_CDOUT = OFF_CDIN + (size_t)2560 * 1024 * 2;
constexpr size_t OFF_MOD = OFF_CDOUT + (size_t)1024 * 1024 * 2;
constexpr size_t OFF_XS = OFF_MOD + (size_t)2 * 3 * 9216 * 4;
constexpr size_t OFF_H = OFF_XS + (size_t)TT * 1024 * 4;
constexpr size_t OFF_A = OFF_H + (size_t)TT * 1024 * 2;
constexpr size_t OFF_BAR = OFF_A + (size_t)TT * 2816 * 2;
constexpr size_t OFF_P = OFF_BAR + 16384;
constexpr size_t OFF_CS = OFF_P + (size_t)11 * 512 * 1024 * 4;
constexpr size_t WS_NEED = OFF_CS + 16384;
constexpr size_t A_Q = OFF_A;
constexpr size_t A_QC = A_Q + (size_t)2 * 12 * SEQ * 64 * 2;
constexpr size_t A_Z = OFF_A + (size_t)TT * 1280 * 2;
constexpr size_t A_KALL = A_Z + (size_t)TT * 512 * 4;
constexpr size_t A_VTALL = A_KALL + (size_t)2 * 4 * NKEY * 64 * 2;
constexpr size_t A_QN = OFF_A;
constexpr size_t A_VTNA = A_QN + (size_t)2 * 8 * SEQ * 64 * 2;
constexpr size_t A_U = OFF_A + (size_t)TT * 1536 * 2;
constexpr size_t A_KNA = A_U + (size_t)TL * 512 * 2;
static_assert(A_QC + (size_t)2 * 12 * 256 * 64 * 2 <= A_Z, "alias overflow");
static_assert(A_VTALL + (size_t)2 * 4 * NKEY * 64 * 2 <= OFF_BAR, "alias overflow");
static_assert(A_VTNA + (size_t)2 * 8 * 64 * NKEY * 2 <= A_U, "alias overflow");
static_assert(A_KNA + (size_t)2 * 8 * NKEY * 64 * 2 <= OFF_BAR, "alias overflow");

struct Params {
    const float* in[21];
    float* out;
    char* ws;
};
typedef const __attribute__((address_space(4))) Params* PP;

__device__ __forceinline__ unsigned cvt_pk_bf16(float lo, float hi) { unsigned r; asm("v_cvt_pk_bf16_f32 %0, %1, %2" : "=v"(r) : "v"(lo), "v"(hi)); return r; }
__device__ __forceinline__ float max3f(float a, float b, float c) { float r; asm("v_max3_f32 %0, %1, %2, %3" : "=v"(r) : "v"(a), "v"(b), "v"(c)); return r; }
__device__ __forceinline__ bf16_t f2bf(float f) { return (bf16_t)(cvt_pk_bf16(f, 0.f) & 0xffffu); }
__device__ __forceinline__ float bf2f(bf16_t b) { return __uint_as_float(((unsigned)b) << 16); }
__device__ __forceinline__ float bflo(unsigned w) { return __uint_as_float(w << 16); }
__device__ __forceinline__ float bfhi(unsigned w) { return __uint_as_float(w & 0xffff0000u); }
__device__ __forceinline__ float fexp2(float x) { return __builtin_amdgcn_exp2f(x); }
__device__ __forceinline__ float frcp(float x) { return __builtin_amdgcn_rcpf(x); }
__device__ __forceinline__ float sigmoidf_(float x) { return frcp(1.0f + fexp2(-x * LOG2E)); }
__device__ __forceinline__ float siluf_(float x) { return x * sigmoidf_(x); }
__device__ __forceinline__ int otid() { int t = threadIdx.x; asm volatile("" : "+v"(t)); return t; }
template <int OFF> __device__ __forceinline__ float shx(float v) { return __int_as_float(__builtin_amdgcn_ds_swizzle(__float_as_int(v), (OFF << 10) | 0x1f)); }
__device__ __forceinline__ float shx32(float v, int lane) { return __int_as_float(__builtin_amdgcn_ds_bpermute((lane ^ 32) << 2, __float_as_int(v))); }
__device__ __forceinline__ float wave_sum(float v, int lane) {
    v += shx32(v, lane); v += shx<16>(v); v += shx<8>(v); v += shx<4>(v); v += shx<2>(v); v += shx<1>(v);
    return v;
}


#define XB_TMO      128
#define XB_XCNT(j)  (256  + 64 * (j))
#define XB_XSUB(j)  (1280 + 64 * (j))
#define XB_XGEN(j)  (2304 + 64 * (j))
#define XB_TOP      3328
#define XB_TOPGEN   3392
#define XCD_BAR_WORDS 3456
#define XB_SPIN_CAP (1u << 20)
__device__ __forceinline__ unsigned xb_ld(unsigned* p)              { return __hip_atomic_load(p, __ATOMIC_RELAXED, __HIP_MEMORY_SCOPE_AGENT); }
__device__ __forceinline__ unsigned xb_add(unsigned* p, unsigned v) { return __hip_atomic_fetch_add(p, v, __ATOMIC_RELAXED, __HIP_MEMORY_SCOPE_AGENT); }
__device__ __forceinline__ unsigned xb_xcc_id() { return (unsigned)__builtin_amdgcn_s_getreg((3 << 11) | 20) & 0xFu; }
#define XB_SPIN(cond, bar) do { unsigned _sp = 0; while (cond) { __builtin_amdgcn_s_sleep(1); \
    if ((++_sp & 255u) == 0u) { if (xb_ld(&(bar)[XB_TMO])) break; if (_sp > XB_SPIN_CAP) { atomicAdd(&(bar)[XB_TMO], 1u); break; } } } } while (0)
struct XcdBarrier { unsigned* bar; unsigned x; volatile LAS unsigned* st; };
__device__ __forceinline__ XcdBarrier xcd_barrier_post(unsigned* bar, volatile LAS unsigned* st) {
    XcdBarrier b; b.bar = bar; b.x = xb_xcc_id(); b.st = st;
    if (threadIdx.x == 0) (void)xb_add(&bar[XB_XCNT(b.x)], 1u);
    return b;
}
__device__ __forceinline__ void xcd_barrier_complete(unsigned* bar, unsigned x, unsigned& nloc, unsigned& nx) {
    const unsigned G = gridDim.x * gridDim.y * gridDim.z;
    unsigned sum, cnt, mine, sp = 0u;
    for (;;) {
        sum = 0u; cnt = 0u; mine = 0u;
#pragma unroll
        for (unsigned j = 0; j < 16; ++j) { const unsigned c = xb_ld(&bar[XB_XCNT(j)]); sum += c; cnt += (c > 0u) ? 1u : 0u; mine = (j == x) ? c : mine; }
        if (sum == G) break;
        __builtin_amdgcn_s_sleep(1);
        if ((++sp & 255u) == 0u) { if (xb_ld(&bar[XB_TMO])) break; if (sp > XB_SPIN_CAP) { atomicAdd(&bar[XB_TMO], 1u); break; } }
    }
    nloc = mine > 0u ? mine : 1u; nx = cnt > 0u ? cnt : 1u;
}
__device__ __forceinline__ void xcd_barrier(const XcdBarrier& b) {
    asm volatile("s_waitcnt vmcnt(0)" ::: "memory");
    __syncthreads();
    if (threadIdx.x == 0) {
        unsigned* bar = b.bar;
        __builtin_amdgcn_s_waitcnt(0);
        unsigned nloc = b.st[0], nx = b.st[1];
        if (nloc == 0u) { xcd_barrier_complete(bar, b.x, nloc, nx); b.st[0] = nloc; b.st[1] = nx; }
        const unsigned old = xb_add(&bar[XB_XSUB(b.x)], 1u);
        const unsigned gen = old / nloc;
        if (old + 1u == (gen + 1u) * nloc) {
            __builtin_amdgcn_fence(__ATOMIC_RELEASE, "agent");
            asm volatile("s_waitcnt vmcnt(0)" ::: "memory");
            const unsigned og = xb_add(&bar[XB_TOP], 1u);
            const unsigned tg = og / nx;
            if (og + 1u == (tg + 1u) * nx) xb_add(&bar[XB_TOPGEN], 1u);
            else XB_SPIN(xb_ld(&bar[XB_TOPGEN]) == tg, bar);
            __builtin_amdgcn_fence(__ATOMIC_ACQUIRE, "agent");
            xb_add(&bar[XB_XGEN(b.x)], 1u);
            asm volatile("s_waitcnt vmcnt(0)" ::: "memory");
        } else {
            XB_SPIN(xb_ld(&bar[XB_XGEN(b.x)]) == gen, bar);
            __builtin_amdgcn_fence(__ATOMIC_ACQUIRE, "agent");
            asm volatile("s_waitcnt vmcnt(0)" ::: "memory");
        }
    }
    __syncthreads();
}

namespace pg8 {
constexpr int BM = 256, BK = 64, HALF = 128, HTB = HALF * BK * 2, STAGE_BYTES = 8 * HTB, NXCD = 8, WGM = 4;
__device__ __forceinline__ int lds_byte(int r, int c) { const int st = (r >> 4) * 2 + (c >> 5), rr = r & 15, cc = c & 31, ob = rr * 64 + cc * 2; return st * 1024 + (ob ^ (((ob >> 9) & 1) << 5)); }
__device__ __forceinline__ void stage_rc(int b, int& R, int& C) { const int st = b / 1024, sb = b % 1024, swz = sb ^ (((sb >> 9) & 1) << 5); R = (st >> 1) * 16 + swz / 64; C = (st & 1) * 32 + (swz % 64) / 2; }
__device__ __forceinline__ int perm32(int rho) { const int n = rho >> 4, i = rho & 15; return 8 * (i >> 2) + 4 * n + (i & 3); }
struct Unit { int pm, pn, chunk; };
struct Gemm { const bf16_t* A; const bf16_t* Bt; int M, N, K; };
struct StaticOrder {
    int nM, nN, nwg, G, c, nt, nsplit;
    __device__ void init(int M, int N, int K, int G_, int c_, bool split_ctx) {
        nM = M / BM; nN = N / BM; nt = K / BK; G = G_; c = c_; nsplit = 0;
        if (split_ctx) { nM = 64; nsplit = 8 * (nt / 4); }
        nwg = nM * nN;
    }
    __device__ bool next(int i, Unit& u) const {
        const long L = (long)i * G + c;
        const int idx = (int)(L - nwg);
        const bool split = L >= nwg;
        int wgid = split ? 0 : (int)L; { const int q = nwg / NXCD, r = nwg % NXCD, xcd = wgid % NXCD, off = wgid / NXCD; wgid = (xcd < r ? xcd * (q + 1) : r * (q + 1) + (xcd - r) * q) + off; }
        const int nig = WGM * nN, gid = wgid / nig, fm = gid * WGM, gsz = (nM - fm) < WGM ? (nM - fm) : WGM;
        const int pm = fm + ((wgid % nig) % gsz), pn = (wgid % nig) / gsz;
        u.pm = split ? 64 + ((idx >> 2) & 1) : pm; u.pn = split ? (idx & 3) : pn; u.chunk = split ? (idx >> 3) : -1;
        return split ? idx < nsplit : true;
    }
};
template <class Epi>
__device__ __forceinline__ void gemm_phase(LAS unsigned char* lds, const Gemm g, const StaticOrder& S, const Epi& E) {
    const int tid = otid(), wid = __builtin_amdgcn_readfirstlane(tid >> 6), lane = tid & 63, wr = wid >> 2, wc = wid & 3, fr = lane & 15, fq = lane >> 4;
    const int K = g.K;
    unsigned voffA[2], voffB[2];
#pragma unroll
    for (int i = 0; i < 2; ++i) { int R, C; stage_rc(tid * 16 + i * 8192, R, C); const int Rb = (R & ~31) + perm32(R & 31);
        voffA[i] = (unsigned)(R * K + C) * 2u; voffB[i] = (unsigned)(Rb * K + C) * 2u; }
    const size_t kstep = (size_t)(BK * 2);
    const size_t hstep = (size_t)HALF * K * 2;
    const size_t tstep = 2 * hstep;
    const unsigned ldsw = (unsigned)wid * 1024u;
    const int aoff = lds_byte(wr * 64 + fr, fq * 8), boff = lds_byte(wc * 32 + fr, fq * 8);
#define PG8_SA(b, h) (((b) * 2 + (h)) * HTB)
#define PG8_SB(b, h) ((4 + (b) * 2 + (h)) * HTB)
#define PG8_STAGE(bufoff, gbase, voff) do { _Pragma("unroll") for (int _i = 0; _i < 2; ++_i) \
        __builtin_amdgcn_global_load_lds((const unsigned*)((const char*)(gbase) + (voff)[_i]), (LAS unsigned*)(lds + (bufoff) + ldsw + _i * 8192), 16, 0, 0); } while (0)
#define PG8_LDA(dst, b, h) do { _Pragma("unroll") for (int m = 0; m < 4; ++m) _Pragma("unroll") for (int k = 0; k < 2; ++k) dst[m][k] = *(const LAS bf16x8*)(lds + PG8_SA(b, h) + aoff + m * 2048 + k * 1024); } while (0)
#define PG8_LDB(dst, b, h) do { _Pragma("unroll") for (int n = 0; n < 2; ++n) _Pragma("unroll") for (int k = 0; k < 2; ++k) dst[n][k] = *(const LAS bf16x8*)(lds + PG8_SB(b, h) + boff + n * 2048 + k * 1024); } while (0)
#define PG8_MMA(ai, bj, At, Bt) do { __builtin_amdgcn_s_setprio(1); _Pragma("unroll") for (int m = 0; m < 4; ++m) _Pragma("unroll") for (int n = 0; n < 2; ++n) _Pragma("unroll") for (int k = 0; k < 2; ++k) \
        acc[ai][bj][m][n] = __builtin_amdgcn_mfma_f32_16x16x32_bf16(Bt[n][k], At[m][k], acc[ai][bj][m][n], 0, 0, 0); __builtin_amdgcn_s_setprio(0); } while (0)
#define PG8_WAIT_V(n) asm volatile("s_waitcnt vmcnt(" #n ")" ::: "memory")
#define PG8_WAIT_L(n) asm volatile("s_waitcnt lgkmcnt(" #n ")" ::: "memory")
#define PG8_BAR __builtin_amdgcn_s_barrier()
#define PG8_SCHED __builtin_amdgcn_sched_barrier(0)
    Unit cur, nxt; int ui = 0;
    if (!S.next(0, cur)) return;
    f32x4 acc[2][2][4][2];
#pragma unroll
    for (int a = 0; a < 2; ++a)
#pragma unroll
        for (int b = 0; b < 2; ++b)
#pragma unroll
            for (int m = 0; m < 4; ++m)
#pragma unroll
                for (int n = 0; n < 2; ++n) acc[a][b][m][n] = (f32x4){0.f, 0.f, 0.f, 0.f};
    bf16x8 At[4][2], B0[2][2], B1[2][2];
    const char* cA = (const char*)g.A + (size_t)cur.pm * tstep + (size_t)(cur.chunk < 0 ? 0 : cur.chunk * 4) * kstep; const char* cB = (const char*)g.Bt + (size_t)cur.pn * tstep + (size_t)(cur.chunk < 0 ? 0 : cur.chunk * 4) * kstep;
    PG8_STAGE(PG8_SB(0, 0), cB, voffB); PG8_STAGE(PG8_SA(0, 0), cA, voffA); PG8_STAGE(PG8_SB(0, 1), cB + hstep, voffB); PG8_STAGE(PG8_SA(0, 1), cA + hstep, voffA);
    if (wr == 1) PG8_BAR;
    PG8_WAIT_V(4); PG8_BAR;
    PG8_STAGE(PG8_SB(1, 0), cB + kstep, voffB); PG8_STAGE(PG8_SA(1, 0), cA + kstep, voffA); PG8_STAGE(PG8_SB(1, 1), cB + hstep + kstep, voffB);
    PG8_WAIT_V(6); PG8_BAR;
    for (;;) {
        const bool has_next = S.next(ui + 1, nxt);
        const char* nA = has_next ? (const char*)g.A + (size_t)nxt.pm * tstep + (size_t)(nxt.chunk < 0 ? 0 : nxt.chunk * 4) * kstep : cA; const char* nB = has_next ? (const char*)g.Bt + (size_t)nxt.pn * tstep + (size_t)(nxt.chunk < 0 ? 0 : nxt.chunk * 4) * kstep : cB;
        const int nt = cur.chunk < 0 ? S.nt : 4;
        for (int t = 0; t < nt; t += 2) {
            const bool last = (t == nt - 2);
            const char* a1 = cA + (size_t)(t + 1) * kstep;
            const char* a2 = last ? nA : cA + (size_t)(t + 2) * kstep; const char* b2 = last ? nB : cB + (size_t)(t + 2) * kstep;
            const char* a3 = a2 + kstep; const char* b3 = b2 + kstep;
            PG8_LDB(B0, 0, 0); PG8_SCHED; PG8_LDA(At, 0, 0); PG8_STAGE(PG8_SA(1, 1), a1 + hstep, voffA);
            PG8_WAIT_L(8); PG8_BAR; PG8_WAIT_L(0); PG8_MMA(0, 0, At, B0); PG8_BAR; PG8_SCHED;
            PG8_LDB(B1, 0, 1); PG8_STAGE(PG8_SB(0, 0), b2, voffB);
            PG8_BAR; PG8_WAIT_L(0); PG8_MMA(0, 1, At, B1); PG8_BAR;
            PG8_LDA(At, 0, 1); PG8_STAGE(PG8_SA(0, 0), a2, voffA);
            PG8_BAR; PG8_WAIT_L(0); PG8_MMA(1, 0, At, B0); PG8_BAR; PG8_SCHED;
            PG8_STAGE(PG8_SB(0, 1), b2 + hstep, voffB);
            PG8_WAIT_V(6); PG8_BAR; PG8_MMA(1, 1, At, B1); PG8_BAR;
            PG8_LDB(B0, 1, 0); PG8_SCHED; PG8_LDA(At, 1, 0); PG8_STAGE(PG8_SA(0, 1), a2 + hstep, voffA);
            PG8_WAIT_L(8); PG8_BAR; PG8_WAIT_L(0); PG8_MMA(0, 0, At, B0); PG8_BAR; PG8_SCHED;
            PG8_LDB(B1, 1, 1); PG8_STAGE(PG8_SB(1, 0), b3, voffB);
            PG8_BAR; PG8_WAIT_L(0); PG8_MMA(0, 1, At, B1); PG8_BAR;
            PG8_LDA(At, 1, 1); PG8_STAGE(PG8_SA(1, 0), a3, voffA);
            PG8_BAR; PG8_WAIT_L(0); PG8_MMA(1, 0, At, B0); PG8_BAR; PG8_SCHED;
            PG8_STAGE(PG8_SB(1, 1), b3 + hstep, voffB);
            PG8_WAIT_V(6); PG8_BAR; PG8_MMA(1, 1, At, B1); PG8_BAR;
        }
        E(acc, cur, wr, wc, fr, fq);
        if (!has_next) break;
#pragma unroll
        for (int a = 0; a < 2; ++a)
#pragma unroll
            for (int b = 0; b < 2; ++b)
#pragma unroll
                for (int m = 0; m < 4; ++m)
#pragma unroll
                    for (int n = 0; n < 2; ++n) acc[a][b][m][n] = (f32x4){0.f, 0.f, 0.f, 0.f};
        cur = nxt; cA = nA; cB = nB; ++ui;
    }
    PG8_WAIT_V(0);
    if (wr == 0) PG8_BAR;
    PG8_BAR;
#undef PG8_SA
#undef PG8_SB
#undef PG8_STAGE
#undef PG8_LDA
#undef PG8_LDB
#undef PG8_MMA
#undef PG8_WAIT_V
#undef PG8_WAIT_L
#undef PG8_BAR
#undef PG8_SCHED
}
}
using pg8::Unit;
typedef f32x4 AccT[2][2][4][2];

struct EpiSwiglu {
    bf16_t* O;
    __device__ __forceinline__ void operator()(const AccT& acc, const Unit& u, int wr, int wc, int fr, int fq) const {
        const int row0 = u.pm * 256 + wr * 64 + fr, col0 = u.pn * 128 + wc * 32 + 8 * fq;
#pragma unroll
        for (int ai = 0; ai < 2; ++ai)
#pragma unroll
            for (int m = 0; m < 4; ++m) {
                bf16_t* rowp = O + (size_t)(row0 + ai * 128 + m * 16) * DFF + col0;
                float v[8];
#pragma unroll
                for (int n = 0; n < 2; ++n)
#pragma unroll
                    for (int j = 0; j < 4; ++j) { const float g2 = acc[ai][0][m][n][j]; v[n * 4 + j] = (g2 * frcp(1.0f + fexp2(-g2))) * acc[ai][1][m][n][j]; }
                u32x4 w; w.x = cvt_pk_bf16(v[0], v[1]); w.y = cvt_pk_bf16(v[2], v[3]); w.z = cvt_pk_bf16(v[4], v[5]); w.w = cvt_pk_bf16(v[6], v[7]);
                *(u32x4*)rowp = w;
            }
    }
};
struct EpiResid {
    const float* xin_lat; const float* xin_ctx;
    char* ws; int gate_off; int mixout;
    __device__ __forceinline__ void operator()(const AccT& acc, const Unit& u, int wr, int wc, int fr, int fq) const {
        const int row0 = u.pm * 256 + wr * 64 + fr, col0 = u.pn * 256 + wc * 32 + 8 * fq;
        const int v = u.pm < 32 ? 0 : (u.pm < 64 ? 1 : 2);
        const float coef = mixout ? 1.0f : 0.5f;
        float* const xout = (float*)(ws + OFF_XS); float* const P = (float*)(ws + OFF_P);
        const float* gp = (const float*)(ws + OFF_MOD) + gate_off + v * 9216 + col0;
        f32x4 gv[2][2];
#pragma unroll
        for (int bj = 0; bj < 2; ++bj)
#pragma unroll
            for (int n = 0; n < 2; ++n) gv[bj][n] = *(const f32x4*)(gp + bj * 128 + 4 * n) * coef;
        if (u.chunk >= 0) {
            float* pb = P + (size_t)u.chunk * 512 * DM;
#pragma unroll
            for (int ai = 0; ai < 2; ++ai)
#pragma unroll
                for (int m = 0; m < 4; ++m) {
                    const size_t base = (size_t)(row0 - TL + ai * 128 + m * 16) * DM + col0;
#pragma unroll
                    for (int bj = 0; bj < 2; ++bj)
#pragma unroll
                        for (int n = 0; n < 2; ++n) *(f32x4*)(pb + base + bj * 128 + 4 * n) = gv[bj][n] * acc[ai][bj][m][n];
                }
            return;
        }
        const float* src = u.pm < 64 ? xin_lat : xin_ctx;
#pragma unroll
        for (int ai = 0; ai < 2; ++ai)
#pragma unroll
            for (int m = 0; m < 4; ++m) {
                const size_t base = (size_t)(row0 + ai * 128 + m * 16) * DM + col0;
#pragma unroll
                for (int bj = 0; bj < 2; ++bj)
#pragma unroll
                    for (int n = 0; n < 2; ++n) {
                        const f32x4 xv = *(const f32x4*)(src + base + bj * 128 + 4 * n);
                        *(f32x4*)(xout + base + bj * 128 + 4 * n) = xv + gv[bj][n] * acc[ai][bj][m][n];
                    }
            }
    }
};
__device__ __forceinline__ void store_bf16_tile(const AccT& acc, bf16_t* O, int ldo, int row0, int col0) {
#pragma unroll
    for (int ai = 0; ai < 2; ++ai)
#pragma unroll
        for (int m = 0; m < 4; ++m) {
            bf16_t* rowp = O + (size_t)(row0 + ai * 128 + m * 16) * ldo + col0;
#pragma unroll
            for (int bj = 0; bj < 2; ++bj) {
                const f32x4 v0 = acc[ai][bj][m][0], v1 = acc[ai][bj][m][1];
                u32x4 w; w.x = cvt_pk_bf16(v0[0], v0[1]); w.y = cvt_pk_bf16(v0[2], v0[3]); w.z = cvt_pk_bf16(v1[0], v1[1]); w.w = cvt_pk_bf16(v1[2], v1[3]);
                *(u32x4*)(rowp + bj * 128) = w;
            }
        }
}
struct EpiMixIn {
    int layer; char* ws; const float* qn; const float* kn;
    __device__ __forceinline__ void operator()(const AccT& acc, const Unit& u, int wr, int wc, int fr, int fq) const {
        const int row0 = u.pm * 256 + wr * 64 + fr, cw = wc * 32 + 8 * fq;
        const int lane = fq * 16 + fr;
        const bool l0 = layer == 0;
        const int qt0 = l0 ? 0 : 4, nqt = l0 ? 3 : 2, nkt = l0 ? 1 : 2;
        const int rel = u.pn - qt0;
        if (rel >= 0 && rel < nqt + 2 * nkt) {
            const bool isctx = u.pm >= 64;
            const int kind = rel < nqt ? 0 : (rel < nqt + nkt ? 1 : 2);
            const int head = (kind == 0 ? rel : (kind == 1 ? rel - nqt : rel - nqt - nkt)) * 4 + wc;
            const int nqh = l0 ? 12 : 8, nkv = l0 ? 4 : 8;
            if (kind == 2) {
                bf16_t* VT = (bf16_t*)(ws + (l0 ? A_VTALL : A_VTNA));
#pragma unroll
                for (int ai = 0; ai < 2; ++ai)
#pragma unroll
                    for (int m = 0; m < 4; ++m) {
                        const int r = row0 + ai * 128 + m * 16;
                        const int b = isctx ? (r - TL) >> 8 : r >> 13, n = isctx ? (r - TL) & 255 : r & 8191;
                        const int pos = isctx ? n : CTXL + n, ppos = (pos & ~12) | ((pos & 4) << 1) | ((pos & 8) >> 1);
                        bf16_t* dst = VT + (size_t)(b * nkv + head) * 64 * NKEY + ppos;
#pragma unroll
                        for (int bj = 0; bj < 2; ++bj)
#pragma unroll
                            for (int n2 = 0; n2 < 2; ++n2)
#pragma unroll
                                for (int j = 0; j < 4; ++j) dst[(size_t)(32 * bj + 8 * fq + 4 * n2 + j) * NKEY] = f2bf(acc[ai][bj][m][n2][j]);
                    }
            } else if (!(isctx && kind == 0 && !l0)) {
                f32x4 nw[2][2];
                if (l0) { const float* np = (kind == 0 ? qn : kn) + 8 * fq;
#pragma unroll
                    for (int bj = 0; bj < 2; ++bj)
#pragma unroll
                        for (int n2 = 0; n2 < 2; ++n2) nw[bj][n2] = *(const f32x4*)(np + 32 * bj + 4 * n2); }
                const float osc = kind == 0 ? QSCALE : 1.0f;
                float nmax = 0.f;
                const f32x4* cs = (const f32x4*)(ws + OFF_CS);
#pragma unroll
                for (int ai = 0; ai < 2; ++ai)
#pragma unroll
                    for (int m = 0; m < 4; ++m) {
                        const int r = row0 + ai * 128 + m * 16;
                        const int b = isctx ? (r - TL) >> 8 : r >> 13, n = isctx ? (r - TL) & 255 : r & 8191;
                        f32x4 x[2][2];
#pragma unroll
                        for (int bj = 0; bj < 2; ++bj)
#pragma unroll
                            for (int n2 = 0; n2 < 2; ++n2) x[bj][n2] = acc[ai][bj][m][n2];
                        if (!l0) {
                            float ss = 0.f;
#pragma unroll
                            for (int bj = 0; bj < 2; ++bj)
#pragma unroll
                                for (int n2 = 0; n2 < 2; ++n2) ss += x[bj][n2][0] * x[bj][n2][0] + x[bj][n2][1] * x[bj][n2][1] + x[bj][n2][2] * x[bj][n2][2] + x[bj][n2][3] * x[bj][n2][3];
                            ss += shx<16>(ss); ss += shx32(ss, lane);
                            nmax = fmaxf(nmax, ss);
                        }
                        if (l0) {
                            float ss = 0.f;
#pragma unroll
                            for (int bj = 0; bj < 2; ++bj)
#pragma unroll
                                for (int n2 = 0; n2 < 2; ++n2) ss += x[bj][n2][0] * x[bj][n2][0] + x[bj][n2][1] * x[bj][n2][1] + x[bj][n2][2] * x[bj][n2][2] + x[bj][n2][3] * x[bj][n2][3];
                            ss += shx<16>(ss); ss += shx32(ss, lane);
                            const float rs = rsqrtf(ss * (1.0f / 64.0f) + 1e-6f);
#pragma unroll
                            for (int bj = 0; bj < 2; ++bj)
#pragma unroll
                                for (int n2 = 0; n2 < 2; ++n2) x[bj][n2] = x[bj][n2] * rs * nw[bj][n2];
                            if (!isctx) {
                                const int pos = fq < 2 ? (n >> 6) : (n & 63);
                                const f32x4* cp = cs + (pos * 16 + ((8 * fq) & 15)) / 2;
#pragma unroll
                                for (int n2 = 0; n2 < 2; ++n2) {
                                    const f32x4 c01 = cp[n2 * 2], c23 = cp[n2 * 2 + 1];
                                    const float co[4] = {c01[0], c01[2], c23[0], c23[2]}, si[4] = {c01[1], c01[3], c23[1], c23[3]};
#pragma unroll
                                    for (int j = 0; j < 4; ++j) { const float x1 = x[0][n2][j], x2 = x[1][n2][j];
                                        x[0][n2][j] = x1 * co[j] - x2 * si[j]; x[1][n2][j] = x2 * co[j] + x1 * si[j]; }
                                }
                            }
                        }
                        bf16_t* dst;
                        if (kind == 0) dst = isctx ? (bf16_t*)(ws + A_QC) + ((size_t)(b * 12 + head) * CTXL + n) * 64
                                                   : (bf16_t*)(ws + (l0 ? A_Q : A_QN)) + ((size_t)(b * nqh + head) * SEQ + n) * 64;
                        else dst = (bf16_t*)(ws + (l0 ? A_KALL : A_KNA)) + ((size_t)(b * nkv + head) * NKEY + (isctx ? n : CTXL + n)) * 64;
#pragma unroll
                        for (int bj = 0; bj < 2; ++bj) {
                            u32x4 w; w.x = cvt_pk_bf16(x[bj][0][0] * osc, x[bj][0][1] * osc); w.y = cvt_pk_bf16(x[bj][0][2] * osc, x[bj][0][3] * osc);
                            w.z = cvt_pk_bf16(x[bj][1][0] * osc, x[bj][1][1] * osc); w.w = cvt_pk_bf16(x[bj][1][2] * osc, x[bj][1][3] * osc);
                            *(u32x4*)(dst + 32 * bj + 8 * fq) = w;
                        }
                    }
                if (!l0) {
                    nmax = fmaxf(nmax, shx<8>(nmax)); nmax = fmaxf(nmax, shx<4>(nmax)); nmax = fmaxf(nmax, shx<2>(nmax)); nmax = fmaxf(nmax, shx<1>(nmax));
                    if (lane == 0) (void)__hip_atomic_fetch_max((unsigned*)(ws + OFF_BAR) + (kind == 0 ? 3600 : 3664), __float_as_uint(nmax), __ATOMIC_RELAXED, __HIP_MEMORY_SCOPE_AGENT);
                }
            }
        } else if (l0) {
            float* Z = (float*)(ws + A_Z);
            const int col0 = (u.pn - 5) * 256 + cw;
#pragma unroll
            for (int ai = 0; ai < 2; ++ai)
#pragma unroll
                for (int m = 0; m < 4; ++m) {
                    float* rowp = Z + (size_t)(row0 + ai * 128 + m * 16) * 512 + col0;
#pragma unroll
                    for (int bj = 0; bj < 2; ++bj)
#pragma unroll
                        for (int n = 0; n < 2; ++n) *(f32x4*)(rowp + bj * 128 + 4 * n) = acc[ai][bj][m][n];
                }
        } else if (u.pm < 64) {
            bf16_t* U = (bf16_t*)(ws + A_U);
            const int col0 = u.pn * 128 + cw;
#pragma unroll
            for (int ai = 0; ai < 2; ++ai)
#pragma unroll
                for (int m = 0; m < 4; ++m) {
                    bf16_t* rowp = U + (size_t)(row0 + ai * 128 + m * 16) * 512 + col0;
                    float v[8];
#pragma unroll
                    for (int n = 0; n < 2; ++n)
#pragma unroll
                        for (int j = 0; j < 4; ++j) v[n * 4 + j] = acc[ai][0][m][n][j] * frcp(1.0f + fexp2(-acc[ai][1][m][n][j]));
                    u32x4 w; w.x = cvt_pk_bf16(v[0], v[1]); w.y = cvt_pk_bf16(v[2], v[3]); w.z = cvt_pk_bf16(v[4], v[5]); w.w = cvt_pk_bf16(v[6], v[7]);
                    *(u32x4*)rowp = w;
                }
        }
    }
};

__device__ __forceinline__ void conv_tile(float* tl, const float* src, int ld, int col0, int k0, bf16_t* dst, int K) {
    const int tid = otid();
    { const int r = tid >> 4, c4 = (tid & 15) * 4;
#pragma unroll
      for (int i = 0; i < 2; ++i) { const int kk = r + 32 * i; const f32x4 v = *(const f32x4*)(src + (size_t)(k0 + kk) * ld + col0 + c4);
          tl[kk * 65 + c4 + 0] = v[0]; tl[kk * 65 + c4 + 1] = v[1]; tl[kk * 65 + c4 + 2] = v[2]; tl[kk * 65 + c4 + 3] = v[3]; } }
    __syncthreads();
    { const int nn = tid >> 3, kc = (tid & 7) * 8; float v[8];
#pragma unroll
      for (int j = 0; j < 8; ++j) v[j] = tl[(kc + j) * 65 + nn];
      u32x4 w; w.x = cvt_pk_bf16(v[0], v[1]); w.y = cvt_pk_bf16(v[2], v[3]); w.z = cvt_pk_bf16(v[4], v[5]); w.w = cvt_pk_bf16(v[6], v[7]);
      *(u32x4*)(dst + (size_t)nn * K + kc) = w; }
    __syncthreads();
}

__device__ void transpose_tiles(PP pp, char* lds, int part, int first, int stride, int total) {
    const int tid = otid();
    float* fl = (float*)lds;
    const int wid = __builtin_amdgcn_readfirstlane(tid >> 6), lane = tid & 63;
    float* wl = fl + 3200 + wid * (64 * 33);
    for (int it4 = first; it4 * 4 < total; it4 += stride) {
        int u = it4 * 4 + (wid >> 1); const int nh = wid & 1;
        const bool valid = u < total;
        if (!valid) u = 0;
        int t = u;
        if (part == 11) t = u < 704 ? 5632 + u : (u < 1024 ? 8448 + (u - 704) : 1408 + (u - 1024));
        if (part == 12) t = u < 256 ? 8768 + u : 6336 + (u - 256);
        if (part == 13) t = u < 1408 ? 2816 + u : 7040 + (u - 1408);
        if (part == 14) t = u < 640 ? 9024 + u : 4224 + (u - 640);
        if (part == 15) t = u < 256 ? 9664 + u : 7744 + (u - 256);
        const float* src; int ld, col0, K, ntk; bf16_t* dst; int j; bool perm = false; float wsc = 1.0f;
        if (t < 5632) {
            const int w = t / 1408; t %= 1408; K = 1024; ntk = 16; j = t / ntk;
            const int pn = j >> 2, q = j & 3;
            src = (q < 2 ? pp->in[6] : pp->in[7]) + (size_t)w * 1024 * 2816; ld = 2816; col0 = pn * 128 + (q & 1) * 64;
            wsc = q < 2 ? LOG2E : 1.0f / LOG2E;
            dst = (bf16_t*)(pp->ws + OFF_W1T + w * SZ_W1T);
        } else if (t < 5632 + 2816) {
            t -= 5632; const int w = t / 704; t %= 704; K = 2816; ntk = 44; j = t / ntk;
            src = pp->in[8] + (size_t)w * 2816 * 1024; ld = 1024; col0 = j * 64;
            dst = (bf16_t*)(pp->ws + OFF_W2T + w * SZ_W2T);
        } else if (t < 8448 + 320) {
            t -= 8448; K = 1024; ntk = 16; j = t / ntk; src = pp->in[9]; ld = 1536; col0 = j * 64; dst = (bf16_t*)(pp->ws + OFF_ABIN); perm = true;
        } else if (t < 8768 + 256) {
            t -= 8768; K = 1024; ntk = 16; j = t / ntk; src = pp->in[10]; ld = 1024; col0 = j * 64; dst = (bf16_t*)(pp->ws + OFF_ABOUT);
        } else if (t < 9024 + 640) {
            t -= 9024; K = 1024; ntk = 16; j = t / ntk; src = pp->in[13]; ld = 2560;
            if (j < 16) { const int pn = j >> 2, q = j & 3; col0 = (q < 2 ? 0 : 512) + pn * 128 + (q & 1) * 64; if (q >= 2) wsc = LOG2E;   } else { col0 = j * 64; perm = true; }
            dst = (bf16_t*)(pp->ws + OFF_CDIN);
        } else {
            t -= 9664; K = 1024; ntk = 16; j = t / ntk; src = pp->in[14]; ld = 1024; col0 = j * 64; dst = (bf16_t*)(pp->ws + OFF_CDOUT);
        }
        const int k0 = (t % ntk) * 64;
        int scol = col0 + nh * 32;
        if (perm) { const int C = j * 2 + nh, c8 = C & 7; scol = ((C >> 3) * 8 + (c8 & 3) * 2 + (c8 >> 2)) * 32; }
        const float* sp = src + (size_t)(k0 + (lane >> 3)) * ld + scol + (lane & 7) * 4;
        f32x4 v[8];
#pragma unroll
        for (int i = 0; i < 8; ++i) v[i] = __builtin_nontemporal_load((const f32x4*)(sp + (size_t)(8 * i) * ld));
#pragma unroll
        for (int i = 0; i < 8; ++i) { float* q = wl + (8 * i + (lane >> 3)) * 33 + (lane & 7) * 4; q[0] = v[i][0] * wsc; q[1] = v[i][1] * wsc; q[2] = v[i][2] * wsc; q[3] = v[i][3] * wsc; }
        __syncthreads();
        { const int nn = lane >> 1, kh = (lane & 1) * 32;
          bf16_t* dp = dst + (size_t)(j * 64 + nh * 32 + nn) * K + k0 + kh;
#pragma unroll
          for (int c = 0; c < 4; ++c) { float f[8];
#pragma unroll
              for (int e = 0; e < 8; ++e) f[e] = wl[(kh + c * 8 + e) * 33 + nn];
              u32x4 w; w.x = cvt_pk_bf16(f[0], f[1]); w.y = cvt_pk_bf16(f[2], f[3]); w.z = cvt_pk_bf16(f[4], f[5]); w.w = cvt_pk_bf16(f[6], f[7]);
              if (valid) *(u32x4*)(dp + c * 8) = w; } }
        __syncthreads();
    }
}

__device__ void prep_items(PP pp, char* lds, int lo, int hi, int first, int stride, bool rope_table) {
    const int tid = otid();
    float* fl = (float*)lds;
    for (int i = tid; i < 3072; i += 512) { const float c = i < 2048 ? pp->in[1][i] : pp->in[3][i - 2048]; fl[i] = c / (1.0f + expf(-c)); }
    float* ct = fl + 3072;
    float* st = fl + 3136;
    if (tid < 64) { float s, c; sincospif((float)tid / 32.0f, &s, &c); ct[tid] = c; st[tid] = s; }
    if (rope_table && blockIdx.x == gridDim.x - 1) {
        f32x2* cst = (f32x2*)(pp->ws + OFF_CS);
        for (int i = tid; i < 2048; i += 512) { const int pos = i >> 4, jj = i & 15; const float inv = powf(10000.0f, -(float)jj / 16.0f); const float ang = (float)pos * inv;
            float sn, cn; sincosf(ang, &sn, &cn); cst[i] = (f32x2){cn, sn}; }
    }
    float* red = fl + 3200;
    float* tl = fl + 3200;
    __syncthreads();
    constexpr int N_GEMV = 288, N_Z = 64, N_TR = 9920;
    for (int item = lo + first; item < hi; item += stride) {
        if (item < N_GEMV) {
            const int layer = item / 144, n0 = (item % 144) * 64, cl = tid & 15, ks = tid >> 4;
            const float* W = pp->in[4] + ((size_t)layer * 1024 + ks * 32) * 9216 + n0 + cl * 4;
            float a[3][4];
#pragma unroll
            for (int v = 0; v < 3; ++v)
#pragma unroll
                for (int j = 0; j < 4; ++j) a[v][j] = 0.f;
#pragma unroll 8
            for (int kk = 0; kk < 32; ++kk) {
                const f32x4 w = __builtin_nontemporal_load((const f32x4*)(W + (size_t)kk * 9216));
#pragma unroll
                for (int v = 0; v < 3; ++v) { const float s = fl[v * 1024 + ks * 32 + kk];
#pragma unroll
                    for (int j = 0; j < 4; ++j) a[v][j] += s * w[j]; }
            }
#pragma unroll
            for (int v = 0; v < 3; ++v)
#pragma unroll
                for (int j = 0; j < 4; ++j) red[(ks * 16 + cl) * 12 + v * 4 + j] = a[v][j];
            __syncthreads();
            if (tid < 192) { const int c2 = tid / 12, vj = tid % 12, v = vj >> 2, j = vj & 3; float s = 0.f;
                for (int k2 = 0; k2 < 32; ++k2) s += red[(k2 * 16 + c2) * 12 + vj];
                const int n = n0 + c2 * 4 + j;
                ((float*)(pp->ws + OFF_MOD))[(layer * 3 + v) * 9216 + n] = s + pp->in[5][layer * 9216 + n]; }
            __syncthreads();
        } else if (item < N_GEMV + N_Z) {
            const int zi = item - N_GEMV, g = zi >> 4, k0 = (zi & 15) * 64;
            const float* src = pp->in[9];
            { const int r = tid >> 4, c4 = (tid & 15) * 4;
#pragma unroll
              for (int i = 0; i < 2; ++i) { const int kk = r + 32 * i; const f32x4 v = *(const f32x4*)(src + (size_t)(k0 + kk) * 1536 + 1280 + g * 64 + c4);
                  tl[kk * 65 + c4 + 0] = v[0]; tl[kk * 65 + c4 + 1] = v[1]; tl[kk * 65 + c4 + 2] = v[2]; tl[kk * 65 + c4 + 3] = v[3]; } }
            __syncthreads();
            const int kk = tid & 63, mp0 = tid >> 6;
            bf16_t* dst = (bf16_t*)(pp->ws + OFF_ABIN) + (size_t)(1280 + g * 128) * 1024 + k0 + kk;
            for (int e = 0; e < 16; ++e) {
                const int nl = mp0 * 16 + e, m = nl >> 1, part = nl & 1;
                float s = 0.f;
                for (int c = 0; c < 64; ++c) { const int idx = (m * c) & 63; const float t = part ? -st[idx] : ct[idx]; s += tl[kk * 65 + c] * t; }
                dst[(size_t)nl * 1024] = f2bf(s);
            }
            __syncthreads();
        }
    }
    __syncthreads();
}

__device__ void prep_phase(PP pp, char* lds) {
    constexpr int N_TR = 9920;
    if (gridDim.x == 256) prep_items(pp, lds, 0, 288, blockIdx.x, gridDim.x, true);
    else prep_items(pp, lds, 0, 352, blockIdx.x, gridDim.x, true);
    if (gridDim.x == 256) transpose_tiles(pp, lds, 10, blockIdx.x, gridDim.x, 1408);
    else transpose_tiles(pp, lds, 0, blockIdx.x, gridDim.x, N_TR);
}

__device__ void norm_phase(const float* xlat, const float* xctx, int nrows, const float* modl, int si, int ci, bf16_t* h, int cmode, int nch, float* xs, const float* P) {
    const int tid = otid(), wid = tid >> 6, lane = tid & 63;
    const int nw = gridDim.x * 8;
    const int w0 = blockIdx.x * 8 + wid;
    const int nlat = nrows < TL ? nrows : TL, nctx = nrows - nlat;
    const int npre = (nctx > 0 && (w0 & 3) == 3) ? (nctx - (w0 >> 2) + (nw >> 2) - 1) / (nw >> 2) : 0;
    const int npair = (nlat - w0 + 2 * nw - 1) / (2 * nw);
    for (int itn = 0; itn < npre + (npair > 0 ? npair : 0); ++itn) {
        const bool pre = itn < npre;
        const int r0 = pre ? TL + (w0 >> 2) + itn * (nw >> 2) : w0 + (itn - npre) * 2 * nw;
        const int r1 = r0 + nw; const bool has1 = !pre && r1 < nlat;
        const int rr[2] = {r0, has1 ? r1 : r0};
        f32x4 x[2][4]; float ss[2] = {0.f, 0.f};
#pragma unroll
        for (int q = 0; q < 2; ++q) {
            const int r = rr[q];
            const float* src = r < TL ? xlat + (size_t)r * DM : xctx + (size_t)(r - TL) * DM;
#pragma unroll
            for (int i = 0; i < 4; ++i) x[q][i] = *(const f32x4*)(src + i * 256 + lane * 4);
        }
#pragma unroll
        for (int q = 0; q < 2; ++q) {
            const int r = rr[q];
            if (r >= TL && cmode != 0 && (q == 0 || has1)) {
                if (cmode == 2) {
                    for (int c = 0; c < nch; ++c) {
                        const float* pp = P + ((size_t)c * 512 + (r - TL)) * DM;
#pragma unroll
                        for (int i = 0; i < 4; ++i) x[q][i] += *(const f32x4*)(pp + i * 256 + lane * 4);
                    }
                }
#pragma unroll
                for (int i = 0; i < 4; ++i) *(f32x4*)(xs + (size_t)r * DM + i * 256 + lane * 4) = x[q][i];
            }
#pragma unroll
            for (int i = 0; i < 4; ++i) ss[q] += x[q][i][0] * x[q][i][0] + x[q][i][1] * x[q][i][1] + x[q][i][2] * x[q][i][2] + x[q][i][3] * x[q][i][3];
            ss[q] = wave_sum(ss[q], lane);
        }
#pragma unroll
        for (int q = 0; q < 2; ++q) {
            if (q == 1 && !has1) break;
            const int r = rr[q];
            const int v = r < SEQ ? 0 : (r < TL ? 1 : 2);
            const float* sh = modl + v * 9216 + si * 1024; const float* sc = modl + v * 9216 + ci * 1024;
            const float rs = rsqrtf(ss[q] * (1.0f / 1024.0f) + 1e-6f);
#pragma unroll
            for (int i = 0; i < 4; ++i) {
                const f32x4 s4 = *(const f32x4*)(sc + i * 256 + lane * 4), h4 = *(const f32x4*)(sh + i * 256 + lane * 4);
                const f32x4 y = x[q][i] * rs * (s4 + 1.0f) + h4;
                u32x2 w; w.x = cvt_pk_bf16(y[0], y[1]); w.y = cvt_pk_bf16(y[2], y[3]);
                *(u32x2*)(h + (size_t)r * DM + i * 256 + lane * 4) = w;
            }
        }
    }
}
__device__ void final_phase(const float* xs, const float* fn, float* out) {
    const int tid = otid(), wid = tid >> 6, lane = tid & 63;
    for (int r = blockIdx.x * 8 + wid; r < TL; r += gridDim.x * 8) {
        const float* src = xs + (size_t)r * DM;
        f32x4 x[4]; float ss = 0.f;
#pragma unroll
        for (int i = 0; i < 4; ++i) { x[i] = *(const f32x4*)(src + i * 256 + lane * 4); ss += x[i][0] * x[i][0] + x[i][1] * x[i][1] + x[i][2] * x[i][2] + x[i][3] * x[i][3]; }
        ss = wave_sum(ss, lane);
        const float rs = rsqrtf(ss * (1.0f / 1024.0f) + 1e-6f);
#pragma unroll
        for (int i = 0; i < 4; ++i) { const f32x4 w4 = *(const f32x4*)(fn + i * 256 + lane * 4); *(f32x4*)(out + (size_t)r * DM + i * 256 + lane * 4) = x[i] * rs * w4; }
    }
}

constexpr int AT_STAGE = 9216 + 9216, AT_RPB = 3 * AT_STAGE;
template <bool NOMAX>
__device__ __forceinline__ void attn_item(char* lds, const bf16_t* Qp, const bf16_t* Kp, const bf16_t* VTp, int ldv, int ntiles, bf16_t* Op, int ldo) {
    const int tid = otid(), wid = __builtin_amdgcn_readfirstlane(tid >> 6), lane = tid & 63;
    const int lr = lane & 31, lh = lane >> 5;
    bf16x8 qf[4];
#pragma unroll
    for (int kk = 0; kk < 4; ++kk) qf[kk] = *(const bf16x8*)(Qp + (size_t)(32 * wid + lr) * 64 + 16 * kk + 8 * lh);
    f32x16 o[2];
#pragma unroll
    for (int b = 0; b < 2; ++b)
#pragma unroll
        for (int i = 0; i < 16; ++i) o[b][i] = 0.f;
    float mrun = -1e30f, lrun = 0.f;
    u32x4 kreg, vreg;
    const bf16_t* kgp = Kp + tid * 8; const bf16_t* vgp = VTp + (size_t)(tid >> 3) * ldv + (tid & 7) * 8;
    const int kls = (tid >> 3) * 144 + (tid & 7) * 16, vls = 9216 + (tid >> 3) * 144 + (tid & 7) * 16;
    const int kfo = lr * 144 + lh * 16, vfo = 9216 + lr * 144 + lh * 16;
#define AT_SCHED __builtin_amdgcn_sched_barrier(0)
#define AT_GLOAD(t_) do { kreg = *(const u32x4*)(kgp + (size_t)(t_) * 4096); vreg = *(const u32x4*)(vgp + (t_) * 64); } while (0)
#define AT_LSTORE(s_) do { *(u32x4*)(lds + (s_) * AT_STAGE + kls) = kreg; *(u32x4*)(lds + (s_) * AT_STAGE + vls) = vreg; } while (0)
#define AT_KLOAD(KF, st_, kb_) do { const char* Ks_ = lds + (st_) * AT_STAGE + kfo + (kb_) * 4608; \
        _Pragma("unroll") for (int kk = 0; kk < 4; ++kk) KF[kk] = *(const bf16x8*)(Ks_ + kk * 32); } while (0)
#define AT_QKMMA(S, KF) do { \
        _Pragma("unroll") for (int i = 0; i < 16; ++i) S[i] = 0.f; \
        _Pragma("unroll") for (int kk = 0; kk < 4; ++kk) S = __builtin_amdgcn_mfma_f32_32x32x16_bf16(KF[kk], qf[kk], S, 0, 0, 0); } while (0)
#define AT_VLOAD(VF, st_, kb_) do { const char* Vs_ = lds + (st_) * AT_STAGE + vfo + (kb_) * 64; \
        _Pragma("unroll") for (int sl = 0; sl < 2; ++sl) _Pragma("unroll") for (int db = 0; db < 2; ++db) VF[sl][db] = *(const bf16x8*)(Vs_ + db * 4608 + sl * 32); } while (0)
#define AT_PVMMA(VF, PF) do { \
        _Pragma("unroll") for (int sl = 0; sl < 2; ++sl) _Pragma("unroll") for (int db = 0; db < 2; ++db) \
            o[db] = __builtin_amdgcn_mfma_f32_32x32x16_bf16(VF[sl][db], PF[sl], o[db], 0, 0, 0); } while (0)
#define AT_PACK(PF, S) do { _Pragma("unroll") for (int sl = 0; sl < 2; ++sl) { \
            u32x4 w_; w_.x = cvt_pk_bf16(S[8 * sl + 0], S[8 * sl + 1]); w_.y = cvt_pk_bf16(S[8 * sl + 2], S[8 * sl + 3]); \
            w_.z = cvt_pk_bf16(S[8 * sl + 4], S[8 * sl + 5]); w_.w = cvt_pk_bf16(S[8 * sl + 6], S[8 * sl + 7]); PF[sl] = __builtin_bit_cast(bf16x8, w_); } } while (0)
#define AT_STEP(SC, SN, T, HASN) do { const int t_ = (T); \
        constexpr bool hasn_ = HASN; \
        if (t_ + 2 < ntiles) AT_GLOAD(t_ + 2); \
        bf16x8 kfa_[4], kfb_[4]; bf16x8 vf0_[2][2], vf1_[2][2]; bf16x8 pf0_[2], pf1_[2]; \
        if (hasn_) AT_KLOAD(kfa_, sn, 0); \
        AT_SCHED; \
        if (hasn_) { AT_KLOAD(kfb_, sn, 1); AT_SCHED; AT_QKMMA(SN[0], kfa_); } \
        AT_VLOAD(vf0_, sc, 0); \
        AT_SCHED; \
        if (hasn_) AT_QKMMA(SN[1], kfb_); \
        AT_SCHED; \
        { \
            if constexpr (!NOMAX) { \
            float mx_ = max3f(SC[0][0], SC[1][0], SC[0][1]), my_ = max3f(SC[1][1], SC[0][2], SC[1][2]); \
            _Pragma("unroll") for (int i = 3; i < 15; i += 2) { mx_ = max3f(mx_, SC[0][i], SC[1][i]); my_ = max3f(my_, SC[0][i + 1], SC[1][i + 1]); } \
            mx_ = max3f(mx_, SC[0][15], SC[1][15]); mx_ = fmaxf(mx_, my_); \
            mx_ = fmaxf(mx_, shx32(mx_, lane)); \
            if (__builtin_amdgcn_ballot_w64(mx_ > mrun) != 0ull) { \
                const float mn_ = fmaxf(mrun, mx_); \
                const float alpha_ = fexp2(mrun - mn_); \
                mrun = mn_; \
                lrun *= alpha_; \
                _Pragma("unroll") for (int db = 0; db < 2; ++db) \
                _Pragma("unroll") for (int i = 0; i < 16; ++i) o[db][i] *= alpha_; \
            } \
            _Pragma("unroll") for (int kb = 0; kb < 2; ++kb) \
            _Pragma("unroll") for (int i = 0; i < 16; ++i) SC[kb][i] -= mrun; \
            } \
            float sum0_ = 0.f, sum1_ = 0.f, sum2_ = 0.f, sum3_ = 0.f; \
            _Pragma("unroll") for (int i = 0; i < 16; i += 4) { SC[0][i] = fexp2(SC[0][i]); SC[0][i + 1] = fexp2(SC[0][i + 1]); SC[0][i + 2] = fexp2(SC[0][i + 2]); SC[0][i + 3] = fexp2(SC[0][i + 3]); \
                sum0_ += SC[0][i]; sum1_ += SC[0][i + 1]; sum2_ += SC[0][i + 2]; sum3_ += SC[0][i + 3]; } \
            AT_PACK(pf0_, SC[0]); \
            AT_SCHED; \
            AT_VLOAD(vf1_, sc, 1); \
            AT_PVMMA(vf0_, pf0_); \
            AT_SCHED; \
            _Pragma("unroll") for (int i = 0; i < 16; i += 4) { SC[1][i] = fexp2(SC[1][i]); SC[1][i + 1] = fexp2(SC[1][i + 1]); SC[1][i + 2] = fexp2(SC[1][i + 2]); SC[1][i + 3] = fexp2(SC[1][i + 3]); \
                sum0_ += SC[1][i]; sum1_ += SC[1][i + 1]; sum2_ += SC[1][i + 2]; sum3_ += SC[1][i + 3]; } \
            lrun += (sum0_ + sum1_) + (sum2_ + sum3_); \
            AT_PACK(pf1_, SC[1]); \
            AT_SCHED; \
            AT_PVMMA(vf1_, pf1_); \
        } \
        if (t_ + 2 < ntiles) AT_LSTORE(sp); \
        { const int tmp_ = sc; sc = sn; sn = sp; sp = tmp_; } \
        __syncthreads(); } while (0)
    int sc = 0, sn = 1, sp = 2;
    AT_GLOAD(0); AT_LSTORE(0);
    if (ntiles > 1) { AT_GLOAD(1); AT_LSTORE(1); }
    __syncthreads();
    f32x16 sa[2], sb[2];
    { bf16x8 kfa_[4], kfb_[4]; AT_KLOAD(kfa_, 0, 0); AT_KLOAD(kfb_, 0, 1); AT_QKMMA(sa[0], kfa_); AT_QKMMA(sa[1], kfb_); }
    for (int t = 0; t < ntiles - 2; t += 2) {
        AT_STEP(sa, sb, t, true);
        AT_STEP(sb, sa, t + 1, true);
    }
    AT_STEP(sa, sb, ntiles - 2, true);
    AT_STEP(sb, sa, ntiles - 1, false);
#undef AT_GLOAD
#undef AT_LSTORE
#undef AT_KLOAD
#undef AT_QKMMA
#undef AT_VLOAD
#undef AT_PVMMA
#undef AT_PACK
#undef AT_SCHED
#undef AT_STEP
    {
        float l = lrun + shx32(lrun, lane);
        const float inv = 1.0f / l;
        bf16_t* orow = Op + (size_t)(32 * wid + lr) * ldo;
#pragma unroll
        for (int db = 0; db < 2; ++db)
#pragma unroll
            for (int i4 = 0; i4 < 4; ++i4) {
                u32x2 w; w.x = cvt_pk_bf16(o[db][i4 * 4 + 0] * inv, o[db][i4 * 4 + 1] * inv); w.y = cvt_pk_bf16(o[db][i4 * 4 + 2] * inv, o[db][i4 * 4 + 3] * inv);
                *(u32x2*)(orow + 32 * db + 8 * i4 + 4 * lh) = w;
            }
    }
}

template <bool NA, bool NOMAX>
__device__ __forceinline__ void attn_item_na(char* lds, const bf16_t* Qp, const bf16_t* Kp, const bf16_t* VTp, int ldv, int ntiles, int toff,
                                          bf16_t* Op, int ldo, int na_r0, int na_rs0) {
    const int tid = otid(), wid = __builtin_amdgcn_readfirstlane(tid >> 6), lane = tid & 63;
    const int lr = lane & 31, lh = lane >> 5;
    const float* rpbs = (const float*)(lds + AT_RPB);
    bf16x8 qf[4];
#pragma unroll
    for (int kk = 0; kk < 4; ++kk) qf[kk] = *(const bf16x8*)(Qp + (size_t)(32 * wid + lr) * 64 + 16 * kk + 8 * lh);
    f32x16 o[2];
#pragma unroll
    for (int b = 0; b < 2; ++b)
#pragma unroll
        for (int i = 0; i < 16; ++i) o[b][i] = 0.f;
    float mrun = -1e30f, lrun = 0.f;
    u32x4 kreg, vreg;
    const int na_r = na_r0 + (wid >> 1);
    const int na_rs = min(max(na_r - 4, 0), 120);
    const int na_c = 32 * (wid & 1) + lr, na_cst = min(max(na_c - 8, 0), 48);
    float madd[2][16];
    if (NA) {
#pragma unroll
        for (int kb = 0; kb < 2; ++kb)
#pragma unroll
            for (int i = 0; i < 16; ++i) { const int kc = 32 * kb + (i & 3) + 8 * (i >> 2) + 4 * lh; madd[kb][i] = (unsigned)(kc - na_cst) < 16u ? 0.f : -1e30f; }
    }
#define AT_GLOAD(t_) do { const int kt_ = (t_) < 4 ? (t_) : (t_) + toff; \
        kreg = *(const u32x4*)(Kp + (size_t)kt_ * 4096 + tid * 8); vreg = *(const u32x4*)(VTp + (size_t)(tid >> 3) * ldv + kt_ * 64 + (tid & 7) * 8); } while (0)
#define AT_LSTORE(s_) do { *(u32x4*)(lds + (s_) * AT_STAGE + (tid >> 3) * 144 + (tid & 7) * 16) = kreg; *(u32x4*)(lds + (s_) * AT_STAGE + 9216 + (tid >> 3) * 144 + (tid & 7) * 16) = vreg; } while (0)
    AT_GLOAD(0); AT_LSTORE(0);
    __syncthreads();
    for (int t = 0; t < ntiles; ++t) {
        if (t + 1 < ntiles) AT_GLOAD(t + 1);
        bool active = true;
        int kr = 0;
        if (NA) { kr = na_rs0 + t - 4; if (t >= 4 && (kr < na_rs || kr >= na_rs + 8)) active = false; }
        if (active) {
            const char* Ks = lds + (t & 1) * AT_STAGE; const char* Vs = Ks + 9216;
            f32x16 s[2];
#pragma unroll
            for (int kb = 0; kb < 2; ++kb) {
#pragma unroll
                for (int i = 0; i < 16; ++i) s[kb][i] = 0.f;
#pragma unroll
                for (int kk = 0; kk < 4; ++kk) {
                    const bf16x8 kf = *(const bf16x8*)(Ks + (32 * kb + lr) * 144 + (16 * kk + 8 * lh) * 2);
                    s[kb] = __builtin_amdgcn_mfma_f32_32x32x16_bf16(kf, qf[kk], s[kb], 0, 0, 0);
                }
            }
            if (NA && t >= 4) {
                const float* rb = rpbs + 64 + (kr - na_r + 7) * 31 + 15 - na_c + 4 * lh;
#pragma unroll
                for (int kb = 0; kb < 2; ++kb)
#pragma unroll
                    for (int i = 0; i < 16; ++i) s[kb][i] = (s[kb][i] + rb[32 * kb + (i & 3) + 8 * (i >> 2)]) + madd[kb][i];
            }
            if constexpr (NOMAX) {
                float sum = 0.f;
#pragma unroll
                for (int kb = 0; kb < 2; ++kb)
#pragma unroll
                    for (int i = 0; i < 16; ++i) { s[kb][i] = fexp2(s[kb][i]); sum += s[kb][i]; }
                lrun += sum;
            } else {
                float mx = s[0][0];
    #pragma unroll
                for (int i = 1; i < 16; ++i) mx = fmaxf(mx, s[0][i]);
    #pragma unroll
                for (int i = 0; i < 16; ++i) mx = fmaxf(mx, s[1][i]);
                mx = fmaxf(mx, shx32(mx, lane));
                const float mn = fmaxf(mrun, mx), alpha = fexp2(mrun - mn);
                mrun = mn;
                float sum = 0.f;
    #pragma unroll
                for (int kb = 0; kb < 2; ++kb)
    #pragma unroll
                    for (int i = 0; i < 16; ++i) { s[kb][i] = fexp2(s[kb][i] - mn); sum += s[kb][i]; }
                lrun = lrun * alpha + sum;
    #pragma unroll
                for (int db = 0; db < 2; ++db)
    #pragma unroll
                    for (int i = 0; i < 16; ++i) o[db][i] *= alpha;
            }
#pragma unroll
            for (int kb = 0; kb < 2; ++kb)
#pragma unroll
                for (int sl = 0; sl < 2; ++sl) {
                    u32x4 w; w.x = cvt_pk_bf16(s[kb][8 * sl + 0], s[kb][8 * sl + 1]); w.y = cvt_pk_bf16(s[kb][8 * sl + 2], s[kb][8 * sl + 3]);
                    w.z = cvt_pk_bf16(s[kb][8 * sl + 4], s[kb][8 * sl + 5]); w.w = cvt_pk_bf16(s[kb][8 * sl + 6], s[kb][8 * sl + 7]);
                    const bf16x8 pf = __builtin_bit_cast(bf16x8, w);
#pragma unroll
                    for (int db = 0; db < 2; ++db) {
                        const bf16x8 vf = *(const bf16x8*)(Vs + (32 * db + lr) * 144 + (32 * kb + 16 * sl + 8 * lh) * 2);
                        o[db] = __builtin_amdgcn_mfma_f32_32x32x16_bf16(vf, pf, o[db], 0, 0, 0);
                    }
                }
        }
        if (t + 1 < ntiles) AT_LSTORE((t + 1) & 1);
        __syncthreads();
    }
#undef AT_GLOAD
#undef AT_LSTORE
    {
        float l = lrun + shx32(lrun, lane);
        const float inv = 1.0f / l;
        bf16_t* orow = Op + (size_t)(32 * wid + lr) * ldo;
#pragma unroll
        for (int db = 0; db < 2; ++db)
#pragma unroll
            for (int i4 = 0; i4 < 4; ++i4) {
                u32x2 w; w.x = cvt_pk_bf16(o[db][i4 * 4 + 0] * inv, o[db][i4 * 4 + 1] * inv); w.y = cvt_pk_bf16(o[db][i4 * 4 + 2] * inv, o[db][i4 * 4 + 3] * inv);
                *(u32x2*)(orow + 32 * db + 8 * i4 + 4 * lh) = w;
            }
    }
}

__device__ void fft_item(char* lds, const float* Z, int row0, int N, int logN, int col, bf16_t* cat, float scale) {
    const int tid = otid();
    f32x2* x = (f32x2*)lds;
    const f32x2* tw = (const f32x2*)(lds + 65536);
    for (int i = tid; i < N; i += 512) x[i] = *(const f32x2*)(Z + (size_t)(row0 + i) * 512 + col * 2);
    __syncthreads();
    for (int lh = logN - 1; lh >= 0; --lh) {
        const int half = 1 << lh, twsh = 12 - lh;
        for (int j = tid; j < (N >> 1); j += 512) {
            const int pos = j & (half - 1), i0 = ((j >> lh) << (lh + 1)) + pos, i1 = i0 + half;
            const f32x2 a = x[i0], b = x[i1], w = tw[pos << twsh];
            const f32x2 d = a - b;
            x[i0] = a + b;
            x[i1] = (f32x2){d.x * w.x - d.y * w.y, d.x * w.y + d.y * w.x};
        }
        __syncthreads();
    }
    for (int i = tid; i < N; i += 512) { const int k = (int)(__brev((unsigned)i) >> (32 - logN)); cat[(size_t)(row0 + k) * DM + 768 + col] = f2bf(x[i].x * scale); }
    __syncthreads();
}

__device__ void mix_ab_phase(PP pp, char* lds) {
    const int tid = otid(), bid = blockIdx.x;
    char* ws = pp->ws;
    bf16_t* cat = (bf16_t*)(ws + OFF_H);
    const float* Z = (const float*)(ws + A_Z);
    { f32x2* tw = (f32x2*)(lds + 65536);
      for (int j = tid; j < 4096; j += 512) { float s, c; sincospif((float)j / 4096.0f, &s, &c); tw[j] = (f32x2){c, -s}; } }
    __syncthreads();
    for (int ci = bid; ci < 1024; ci += gridDim.x) {
        int idx = ci & 511; const bool isctx = ci >= 512;
        if (gridDim.x == 256) idx = (bid & 7) * 64 + (bid >> 3) * 2 + ((ci >> 8) & 1);
        const int b = idx >> 8, col = idx & 255;
        if (!isctx) fft_item(lds, Z, b * SEQ, SEQ, 13, col, cat, 0.001381067932f  );
        else fft_item(lds, Z, TL + b * CTXL, CTXL, 8, col, cat, 0.0078125f  );
    }
    bool nomax;
    { float mq = 0.f, mk = 0.f;
      for (int i = 0; i < 64; ++i) { mq = fmaxf(mq, fabsf(pp->in[11][i])); mk = fmaxf(mk, fabsf(pp->in[12][i])); }
      const float bound = 64.0f * mq * mk * QSCALE;
      nomax = bound < 64.0f; }
    const bf16_t* Q = (const bf16_t*)(ws + A_Q); const bf16_t* QC = (const bf16_t*)(ws + A_QC);
    const bf16_t* Kall = (const bf16_t*)(ws + A_KALL); const bf16_t* VT = (const bf16_t*)(ws + A_VTALL);
    for (int it = bid; it < 24; it += gridDim.x) {
        const int b = it / 12, h = it % 12, kvh = h / 3;
        if (nomax) attn_item<true>(lds, QC + (size_t)(b * 12 + h) * CTXL * 64, Kall + (size_t)(b * 4 + kvh) * NKEY * 64, VT + (size_t)(b * 4 + kvh) * 64 * NKEY, NKEY, 4,
                  cat + (size_t)(TL + b * CTXL) * DM + h * 64, DM);
        else attn_item<false>(lds, QC + (size_t)(b * 12 + h) * CTXL * 64, Kall + (size_t)(b * 4 + kvh) * NKEY * 64, VT + (size_t)(b * 4 + kvh) * 64 * NKEY, NKEY, 4,
                  cat + (size_t)(TL + b * CTXL) * DM + h * 64, DM);
    }
    for (int e = bid; e < 768; e += gridDim.x) {
        int g, qb, bk;
        if (gridDim.x == 256) {
            bk = bid & 7;
            const int idx = (bid >> 3) * 3 + (e >> 8); g = idx % 3; qb = idx / 3;
        } else { g = e % 3; const int r1 = e / 3; qb = r1 & 31; bk = r1 >> 5; }
        const int b = bk >> 2, kvh = bk & 3, h = kvh * 3 + g;
        if (nomax) attn_item<true>(lds, Q + ((size_t)(b * 12 + h) * SEQ + qb * 256) * 64, Kall + (size_t)bk * NKEY * 64, VT + (size_t)bk * 64 * NKEY, NKEY, 132,
                  cat + (size_t)(b * SEQ + qb * 256) * DM + h * 64, DM);
        else attn_item<false>(lds, Q + ((size_t)(b * 12 + h) * SEQ + qb * 256) * 64, Kall + (size_t)bk * NKEY * 64, VT + (size_t)bk * 64 * NKEY, NKEY, 132,
                  cat + (size_t)(b * SEQ + qb * 256) * DM + h * 64, DM);
    }
}

__device__ void conv_item(PP pp, char* lds, int item) {
    const int tid = otid(), wid = tid >> 6, lane = tid & 63;
    const bf16_t* U = (const bf16_t*)(pp->ws + A_U);
    bf16_t* cat2 = (bf16_t*)(pp->ws + OFF_H);
    bf16_t* ut = (bf16_t*)lds;
    float* yt = (float*)(lds + 63488);
    const int t0 = item * 32, b = t0 >> 13, n0 = t0 & 8191;
    for (int c = tid; c < 62 * 64; c += 512) {
        const int rr = c >> 6, part = c & 63, n = n0 - 15 + rr;
        u32x4 v = (u32x4){0u, 0u, 0u, 0u};
        if (n >= 0 && n < SEQ) v = *(const u32x4*)(U + ((size_t)(b * SEQ + n)) * 512 + part * 8);
        *(u32x4*)(ut + rr * 512 + part * 8) = v;
    }
    float w[31];
#pragma unroll
    for (int j = 0; j < 31; ++j) w[j] = pp->in[15][j * 512 + tid];
    const float bias = pp->in[16][tid];
    __syncthreads();
#pragma unroll 1
    for (int tg = 0; tg < 4; ++tg) {
        float y[8];
#pragma unroll
        for (int t = 0; t < 8; ++t) y[t] = bias;
#pragma unroll
        for (int i = 0; i < 38; ++i) {
            const float uv = bf2f(ut[(tg * 8 + i) * 512 + tid]);
#pragma unroll
            for (int t = 0; t < 8; ++t) { const int j = i - t; if (j >= 0 && j < 31) y[t] += uv * w[j]; }
        }
#pragma unroll
        for (int t = 0; t < 8; ++t) yt[(tg * 8 + t) * 516 + tid] = y[t];
    }
    __syncthreads();
    const float* lw = pp->in[17]; const float* lb = pp->in[18];
#pragma unroll 1
    for (int q = 0; q < 4; ++q) {
        const int tok = wid * 4 + q;
        const f32x4 a = *(const f32x4*)(yt + tok * 516 + lane * 8), c = *(const f32x4*)(yt + tok * 516 + lane * 8 + 4);
        float s = a[0] + a[1] + a[2] + a[3] + c[0] + c[1] + c[2] + c[3];
        s = wave_sum(s, lane);
        const float mu = s * (1.0f / 512.0f);
        const f32x4 da = a - mu, dc = c - mu;
        float vs = da[0] * da[0] + da[1] * da[1] + da[2] * da[2] + da[3] * da[3] + dc[0] * dc[0] + dc[1] * dc[1] + dc[2] * dc[2] + dc[3] * dc[3];
        vs = wave_sum(vs, lane);
        const float rs = rsqrtf(vs * (1.0f / 512.0f) + 1e-6f);
        const f32x4 w0 = *(const f32x4*)(lw + lane * 8), w1 = *(const f32x4*)(lw + lane * 8 + 4), b0 = *(const f32x4*)(lb + lane * 8), b1 = *(const f32x4*)(lb + lane * 8 + 4);
        f32x4 y0 = da * rs * w0 + b0, y1 = dc * rs * w1 + b1;
#pragma unroll
        for (int j = 0; j < 4; ++j) { y0[j] = siluf_(y0[j]); y1[j] = siluf_(y1[j]); }
        u32x4 o; o.x = cvt_pk_bf16(y0[0], y0[1]); o.y = cvt_pk_bf16(y0[2], y0[3]); o.z = cvt_pk_bf16(y1[0], y1[1]); o.w = cvt_pk_bf16(y1[2], y1[3]);
        *(u32x4*)(cat2 + (size_t)(t0 + tok) * DM + lane * 8) = o;
    }
    __syncthreads();
}
__device__ void mix_cd_phase(PP pp, char* lds) {
    const int tid = otid(), bid = blockIdx.x;
    char* ws = pp->ws;
    for (int it = bid; it < 512; it += gridDim.x) conv_item(pp, lds, it);
    bool nomax;
    { float bm = 0.f;
      for (int i = tid; i < 8 * 527; i += 512) bm = fmaxf(bm, fabsf(pp->in[19][i]));
      bm = fmaxf(bm, shx32(bm, tid & 63)); bm = fmaxf(bm, shx<16>(bm)); bm = fmaxf(bm, shx<8>(bm)); bm = fmaxf(bm, shx<4>(bm)); bm = fmaxf(bm, shx<2>(bm)); bm = fmaxf(bm, shx<1>(bm));
      float* red = (float*)(lds + 130048);
      if ((tid & 63) == 0) red[tid >> 6] = bm;
      __syncthreads();
      float bb = red[0];
      for (int i = 1; i < 8; ++i) bb = fmaxf(bb, red[i]);
      const unsigned* bw = (const unsigned*)(ws + OFF_BAR);
      const float q2 = __uint_as_float(bw[3600]), k2 = __uint_as_float(bw[3664]);
      const float bound = sqrtf(q2) * sqrtf(k2) * QSCALE * 1.02f + bb * LOG2E;
      nomax = bound < 64.0f;
      __syncthreads(); }
    const bf16_t* QN = (const bf16_t*)(ws + A_QN); const bf16_t* Kna = (const bf16_t*)(ws + A_KNA); const bf16_t* VT = (const bf16_t*)(ws + A_VTNA);
    bf16_t* cat2 = (bf16_t*)(ws + OFF_H);
    for (int it = bid; it < 512; it += gridDim.x) {
        int h, rb, b;
        if (gridDim.x == 256) { const int bh = (bid & 7) + 8 * (it >> 8); b = bh >> 3; h = bh & 7; rb = bid >> 3; }
        else { h = it & 7; rb = (it >> 3) & 31; b = it >> 8; }
        const int r0 = rb * 4;
        const int rs0 = min(max(r0 - 4, 0), 120), rs3 = min(max(r0 + 3 - 4, 0), 120);
        const int ntiles = 4 + (rs3 + 8 - rs0);
        float* rpbs = (float*)(lds + AT_RPB);
        for (int i = tid; i < 64 + 527 + 64; i += 512) rpbs[i] = (i >= 64 && i < 64 + 527) ? pp->in[19][h * 527 + i - 64] * LOG2E : 0.f;
        const bf16_t* qp = QN + ((size_t)(b * 8 + h) * SEQ + r0 * 64) * 64; const bf16_t* kp = Kna + (size_t)(b * 8 + h) * NKEY * 64; const bf16_t* vp = VT + (size_t)(b * 8 + h) * 64 * NKEY;
        bf16_t* op = cat2 + (size_t)(b * SEQ + r0 * 64) * DM + 512 + h * 64;
        if (nomax) attn_item_na<true, true>(lds, qp, kp, vp, NKEY, ntiles, rs0, op, DM, r0, rs0);
        else attn_item_na<true, false>(lds, qp, kp, vp, NKEY, ntiles, rs0, op, DM, r0, rs0);
    }
}

constexpr int NSTEPS = 22;
#define ST(op, a0, a1) ((op) | ((a0) << 4) | ((a1) << 8))
#define STN(a0, a1, nch) (1 | ((a0) << 4) | ((a1) << 8) | ((nch) << 12))
__constant__ int STEP_TAB[NSTEPS] = {
    ST(0, 0, 0),
    STN(0, 1, 0), ST(2, 0, 0), ST(3, 0, 2), STN(3, 4, 11), ST(4, 0, 0), ST(6, 0, 0), ST(3, 2, 5), STN(6, 7, 4), ST(2, 1, 0), ST(3, 1, 8),
    STN(0, 1, 11), ST(2, 0, 0), ST(3, 0, 2), STN(3, 4, 11), ST(4, 0, 0), ST(6, 0, 0), ST(3, 2, 5), STN(6, 7, 0), ST(2, 1, 0), ST(3, 1, 8),
    ST(7, 0, 0)};
__global__ void __launch_bounds__(512, 2) fwd_megakernel(Params p, int s0, int s1) {
    extern __shared__ __attribute__((aligned(16))) unsigned char shm[];
    char* lds = (char*)shm;
    volatile LAS unsigned* bst = (volatile LAS unsigned*)((LAS unsigned char*)shm + 131072);
    if (threadIdx.x == 0) { bst[0] = 0u; bst[1] = 0u; bst[2] = 0u; bst[3] = 0u; }
    __syncthreads();
    XcdBarrier gbar;
    { PP pp0 = (PP)__builtin_amdgcn_kernarg_segment_ptr(); gbar = xcd_barrier_post((unsigned*)(pp0->ws + OFF_BAR), bst); }
    if (s1 > 1000) cg::this_grid().sync();
#ifndef DUP_MASK
#define DUP_MASK 0u
#endif
    for (int sidx = s0; sidx < s1 + (int)__builtin_popcount(DUP_MASK); ++sidx) {
        if (sidx > s0) xcd_barrier(gbar);
        int step = sidx;
        if (DUP_MASK != 0u) { int acc = 0; step = 0; for (int q = 0; q < NSTEPS; ++q) { const int reps = 1 + (int)((DUP_MASK >> q) & 1u); if (sidx >= acc && sidx < acc + reps) step = q; acc += reps; } }
        PP pp = (PP)__builtin_amdgcn_kernarg_segment_ptr();
        asm volatile("" : "+s"(pp));
        char* ws = pp->ws;
        float* xs = (float*)(ws + OFF_XS);
        bf16_t* hbuf = (bf16_t*)(ws + OFF_H);
        bf16_t* act = (bf16_t*)(ws + OFF_A);
        const float* mod = (const float*)(ws + OFF_MOD);
        const int layer = step >= 11 ? 1 : 0;
        const float* modl = mod + layer * 3 * 9216;
        const int code = STEP_TAB[step];
        const int op = code & 15, a0 = (code >> 4) & 15, a1 = (code >> 8) & 15, nch = (code >> 12) & 15;
        const bool tail = step >= 17;
        const int Mrows = tail ? TL : TT;
        if (op == 0) prep_phase(pp, lds);
        else if (op == 1) {
            const bool first = step == 1;
            norm_phase(first ? pp->in[0] : xs, first ? pp->in[2] : xs + (size_t)TL * DM, Mrows, modl, a0, a1, hbuf, first ? 1 : (nch ? 2 : 0), nch, xs, (const float*)(ws + OFF_P));
        } else if (op == 2) {
            pg8::Gemm g{hbuf, (const bf16_t*)(ws + OFF_W1T + (size_t)(layer * 2 + a0) * SZ_W1T), Mrows, 5632, 1024};
            pg8::StaticOrder S; S.init(g.M, g.N, g.K, (int)gridDim.x, (int)blockIdx.x, false);
            EpiSwiglu E{act};
            pg8::gemm_phase(( LAS unsigned char*)shm, g, S, E);
            if (gridDim.x == 256 && blockIdx.x >= 172) {
                if (step == 2) { prep_items(pp, lds, 288, 352, (int)blockIdx.x - 172, 84, false); transpose_tiles(pp, lds, 11, (int)blockIdx.x - 172, 84, 2432); }
                if (step == 9) transpose_tiles(pp, lds, 13, (int)blockIdx.x - 172, 84, 2112);
                if (step == 12) transpose_tiles(pp, lds, 14, (int)blockIdx.x - 172, 84, 2048);
            }
        } else if (op == 3) {
            const bool mixout = a0 == 2, first = step == 3;
            const bf16_t* Bw = (const bf16_t*)(ws + (mixout ? (layer == 0 ? OFF_ABOUT : OFF_CDOUT) : OFF_W2T + (size_t)(layer * 2 + a0) * SZ_W2T));
            const pg8::Gemm g{mixout ? hbuf   : act, Bw, Mrows, 1024, mixout ? 1024 : 2816};
            const float* xl = first ? pp->in[0] : xs; const float* xc = first ? pp->in[2] - (size_t)TL * DM : xs;
            const EpiResid E{xl, xc, ws, layer * 3 * 9216 + a1 * 1024, mixout ? 1 : 0};
            pg8::StaticOrder S; S.init(g.M, g.N, g.K, (int)gridDim.x, (int)blockIdx.x, !tail);
            pg8::gemm_phase((LAS unsigned char*)shm, g, S, E);
        } else if (op == 4) {
            const bool l0 = layer == 0;
            pg8::Gemm g{hbuf, (const bf16_t*)(ws + (l0 ? OFF_ABIN : OFF_CDIN)), TT, l0 ? 1792 : 2560, 1024};
            pg8::StaticOrder S; S.init(g.M, g.N, g.K, (int)gridDim.x, (int)blockIdx.x, false);
            const EpiMixIn E{layer, ws, pp->in[11], pp->in[12]};
            pg8::gemm_phase((LAS unsigned char*)shm, g, S, E);
            if (gridDim.x == 256) {
                if (layer == 0 && blockIdx.x >= 206) transpose_tiles(pp, lds, 12, (int)blockIdx.x - 206, 50, 960);
                if (layer == 1 && blockIdx.x >= 148) transpose_tiles(pp, lds, 15, (int)blockIdx.x - 148, 108, 960);
            }
        } else if (op == 6) {
            if (layer == 0) mix_ab_phase(pp, lds); else mix_cd_phase(pp, lds);
        } else {
            final_phase(xs, pp->in[20], pp->out);
        }
    }
}

extern "C" void kernel_launch(void* const* d_in, const int* in_sizes, int n_in, void* d_out, int out_size, void* d_ws, size_t ws_size, hipStream_t stream) {
    static int grid_blocks = 0;
    if (!grid_blocks) {
        int dev = 0, cus = 0, per_cu = 0;
        hipGetDevice(&dev);
        hipDeviceGetAttribute(&cus, hipDeviceAttributeMultiprocessorCount, dev);
        hipFuncSetAttribute((const void*)fwd_megakernel, hipFuncAttributeMaxDynamicSharedMemorySize, LDS_BYTES);
        hipOccupancyMaxActiveBlocksPerMultiprocessor(&per_cu, fwd_megakernel, 512, LDS_BYTES);
        if (per_cu < 1) per_cu = 1;
        grid_blocks = cus * per_cu;
        if (grid_blocks > 256) grid_blocks = 256;
    }
    Params p{};
    for (int i = 0; i < 21; ++i) p.in[i] = (const float*)d_in[i];
    p.out = (float*)d_out; p.ws = (char*)d_ws;
    if (ws_size < WS_NEED) { fprintf(stderr, "workspace too small: %zu < %zu\n", ws_size, (size_t)WS_NEED); }
    hipMemsetAsync((char*)d_ws + OFF_BAR, 0, 16384, stream);
#if MK_MULTI
    for (int s = 0; s < NSTEPS; ++s) { int s0 = s, s1 = s + 1; hipLaunchKernelGGL(fwd_megakernel, dim3(grid_blocks), dim3(512), LDS_BYTES, stream, p, s0, s1); }
#else
    int s0 = 0, s1 = NSTEPS;
    void* args[] = {&p, &s0, &s1};
    hipError_t e = hipLaunchCooperativeKernel((const void*)fwd_megakernel, dim3(grid_blocks), dim3(512), args, LDS_BYTES, stream);
    if (e != hipSuccess) fprintf(stderr, "cooperative launch failed: %s (grid %d)\n", hipGetErrorString(e), grid_blocks);
#endif
}
```

```cpp
#include <hip/hip_runtime.h>
#include <hip/hip_cooperative_groups.h>
#include <cstdio>
namespace cg = cooperative_groups;

#ifndef MK_MULTI
#define MK_MULTI 0
#endif

#define LAS __attribute__((address_space(3)))
typedef unsigned short bf16_t;
typedef short bf16x8 __attribute__((ext_vector_type(8)));
typedef float f32x4 __attribute__((ext_vector_type(4)));
typedef float f32x2 __attribute__((ext_vector_type(2)));
typedef float f32x16 __attribute__((ext_vector_type(16)));
typedef unsigned u32x4 __attribute__((ext_vector_type(4)));
typedef unsigned u32x2 __attribute__((ext_vector_type(2)));

constexpr int TL = 16384, TCX = 512, TT = 16896, DM = 1024, DFF = 2816;
constexpr int SEQ = 8192, CTXL = 256, NKEY = 8448;
constexpr float LOG2E = 1.4426950408889634f;
constexpr float QSCALE = 0.125f * LOG2E;
constexpr int LDS_BYTES = 131072 + 16;

constexpr size_t SZ_W1T = (size_t)5632 * 1024 * 2, SZ_W2T = (size_t)1024 * 2816 * 2;
constexpr size_t OFF_W1T = 0;
constexpr size_t OFF_W2T = OFF_W1T + 4 * SZ_W1T;
constexpr size_t OFF_ABIN = OFF_W2T + 4 * SZ_W2T;
constexpr size_t OFF_ABOUT = OFF_ABIN + (size_t)1792 * 1024 * 2;
constexpr size_t OFF_CDIN = OFF_ABOUT + (size_t)1024 * 1024 * 2;
constexpr size_t OFF_CDOUT = OFF_CDIN + (size_t)2560 * 1024 * 2;
constexpr size_t OFF_MOD = OFF_CDOUT + (size_t)1024 * 1024 * 2;
constexpr size_t OFF_XS = OFF_MOD + (size_t)2 * 3 * 9216 * 4;
constexpr size_t OFF_H = OFF_XS + (size_t)TT * 1024 * 4;
constexpr size_t OFF_A = OFF_H + (size_t)TT * 1024 * 2;
constexpr size_t OFF_BAR = OFF_A + (size_t)TT * 2816 * 2;
constexpr size_t OFF_P = OFF_BAR + 16384;
constexpr size_t OFF_CS = OFF_P + (size_t)11 * 512 * 1024 * 4;
constexpr size_t WS_NEED = OFF_CS + 16384;
constexpr size_t A_Q = OFF_A;
constexpr size_t A_QC = A_Q + (size_t)2 * 12 * SEQ * 64 * 2;
constexpr size_t A_Z = OFF_A + (size_t)TT * 1280 * 2;
constexpr size_t A_KALL = A_Z + (size_t)TT * 512 * 4;
constexpr size_t A_VTALL = A_KALL + (size_t)2 * 4 * NKEY * 64 * 2;
constexpr size_t A_QN = OFF_A;
constexpr size_t A_VTNA = A_QN + (size_t)2 * 8 * SEQ * 64 * 2;
constexpr size_t A_U = OFF_A + (size_t)TT * 1536 * 2;
constexpr size_t A_KNA = A_U + (size_t)TL * 512 * 2;
static_assert(A_QC + (size_t)2 * 12 * 256 * 64 * 2 <= A_Z, "alias overflow");
static_assert(A_VTALL + (size_t)2 * 4 * NKEY * 64 * 2 <= OFF_BAR, "alias overflow");
static_assert(A_VTNA + (size_t)2 * 8 * 64 * NKEY * 2 <= A_U, "alias overflow");
static_assert(A_KNA + (size_t)2 * 8 * NKEY * 64 * 2 <= OFF_BAR, "alias overflow");

struct Params {
    const float* in[21];
    float* out;
    char* ws;
};
typedef const __attribute__((address_space(4))) Params* PP;

__device__ __forceinline__ unsigned cvt_pk_bf16(float lo, float hi) { unsigned r; asm("v_cvt_pk_bf16_f32 %0, %1, %2" : "=v"(r) : "v"(lo), "v"(hi)); return r; }
__device__ __forceinline__ float max3f(float a, float b, float c) { float r; asm("v_max3_f32 %0, %1, %2, %3" : "=v"(r) : "v"(a), "v"(b), "v"(c)); return r; }
__device__ __forceinline__ bf16_t f2bf(float f) { return (bf16_t)(cvt_pk_bf16(f, 0.f) & 0xffffu); }
__device__ __forceinline__ float bf2f(bf16_t b) { return __uint_as_float(((unsigned)b) << 16); }
__device__ __forceinline__ float bflo(unsigned w) { return __uint_as_float(w << 16); }
__device__ __forceinline__ float bfhi(unsigned w) { return __uint_as_float(w & 0xffff0000u); }
__device__ __forceinline__ float fexp2(float x) { return __builtin_amdgcn_exp2f(x); }
__device__ __forceinline__ float frcp(float x) { return __builtin_amdgcn_rcpf(x); }
__device__ __forceinline__ float sigmoidf_(float x) { return frcp(1.0f + fexp2(-x * LOG2E)); }
__device__ __forceinline__ float siluf_(float x) { return x * sigmoidf_(x); }
__device__ __forceinline__ int otid() { int t = threadIdx.x; asm volatile("" : "+v"(t)); return t; }
template <int OFF> __device__ __forceinline__ float shx(float v) { return __int_as_float(__builtin_amdgcn_ds_swizzle(__float_as_int(v), (OFF << 10) | 0x1f)); }
__device__ __forceinline__ float shx32(float v, int lane) { return __int_as_float(__builtin_amdgcn_ds_bpermute((lane ^ 32) << 2, __float_as_int(v))); }
__device__ __forceinline__ float wave_sum(float v, int lane) {
    v += shx32(v, lane); v += shx<16>(v); v += shx<8>(v); v += shx<4>(v); v += shx<2>(v); v += shx<1>(v);
    return v;
}


#define XB_TMO      128
#define XB_XCNT(j)  (256  + 64 * (j))
#define XB_XSUB(j)  (1280 + 64 * (j))
#define XB_XGEN(j)  (2304 + 64 * (j))
#define XB_TOP      3328
#define XB_TOPGEN   3392
#define XCD_BAR_WORDS 3456
#define XB_SPIN_CAP (1u << 20)
__device__ __forceinline__ unsigned xb_ld(unsigned* p)              { return __hip_atomic_load(p, __ATOMIC_RELAXED, __HIP_MEMORY_SCOPE_AGENT); }
__device__ __forceinline__ unsigned xb_add(unsigned* p, unsigned v) { return __hip_atomic_fetch_add(p, v, __ATOMIC_RELAXED, __HIP_MEMORY_SCOPE_AGENT); }
__device__ __forceinline__ unsigned xb_xcc_id() { return (unsigned)__builtin_amdgcn_s_getreg((3 << 11) | 20) & 0xFu; }
#define XB_SPIN(cond, bar) do { unsigned _sp = 0; while (cond) { __builtin_amdgcn_s_sleep(1); \
    if ((++_sp & 255u) == 0u) { if (xb_ld(&(bar)[XB_TMO])) break; if (_sp > XB_SPIN_CAP) { atomicAdd(&(bar)[XB_TMO], 1u); break; } } } } while (0)
struct XcdBarrier { unsigned* bar; unsigned x; volatile LAS unsigned* st; };
__device__ __forceinline__ XcdBarrier xcd_barrier_post(unsigned* bar, volatile LAS unsigned* st) {
    XcdBarrier b; b.bar = bar; b.x = xb_xcc_id(); b.st = st;
    if (threadIdx.x == 0) (void)xb_add(&bar[XB_XCNT(b.x)], 1u);
    return b;
}
__device__ __forceinline__ void xcd_barrier_complete(unsigned* bar, unsigned x, unsigned& nloc, unsigned& nx) {
    const unsigned G = gridDim.x * gridDim.y * gridDim.z;
    unsigned sum, cnt, mine, sp = 0u;
    for (;;) {
        sum = 0u; cnt = 0u; mine = 0u;
#pragma unroll
        for (unsigned j = 0; j < 16; ++j) { const unsigned c = xb_ld(&bar[XB_XCNT(j)]); sum += c; cnt += (c > 0u) ? 1u : 0u; mine = (j == x) ? c : mine; }
        if (sum == G) break;
        __builtin_amdgcn_s_sleep(1);
        if ((++sp & 255u) == 0u) { if (xb_ld(&bar[XB_TMO])) break; if (sp > XB_SPIN_CAP) { atomicAdd(&bar[XB_TMO], 1u); break; } }
    }
    nloc = mine > 0u ? mine : 1u; nx = cnt > 0u ? cnt : 1u;
}
__device__ __forceinline__ void xcd_barrier(const XcdBarrier& b) {
    asm volatile("s_waitcnt vmcnt(0)" ::: "memory");
    __syncthreads();
    if (threadIdx.x == 0) {
        unsigned* bar = b.bar;
        __builtin_amdgcn_s_waitcnt(0);
        unsigned nloc = b.st[0], nx = b.st[1];
        if (nloc == 0u) { xcd_barrier_complete(bar, b.x, nloc, nx); b.st[0] = nloc; b.st[1] = nx; }
        const unsigned old = xb_add(&bar[XB_XSUB(b.x)], 1u);
        const unsigned gen = old / nloc;
        if (old + 1u == (gen + 1u) * nloc) {
            __builtin_amdgcn_fence(__ATOMIC_RELEASE, "agent");
            asm volatile("s_waitcnt vmcnt(0)" ::: "memory");
            const unsigned og = xb_add(&bar[XB_TOP], 1u);
            const unsigned tg = og / nx;
            if (og + 1u == (tg + 1u) * nx) xb_add(&bar[XB_TOPGEN], 1u);
            else XB_SPIN(xb_ld(&bar[XB_TOPGEN]) == tg, bar);
            __builtin_amdgcn_fence(__ATOMIC_ACQUIRE, "agent");
            xb_add(&bar[XB_XGEN(b.x)], 1u);
            asm volatile("s_waitcnt vmcnt(0)" ::: "memory");
        } else {
            XB_SPIN(xb_ld(&bar[XB_XGEN(b.x)]) == gen, bar);
            __builtin_amdgcn_fence(__ATOMIC_ACQUIRE, "agent");
            asm volatile("s_waitcnt vmcnt(0)" ::: "memory");
        }
    }
    __syncthreads();
}

namespace pg8 {
constexpr int BM = 256, BK = 64, HALF = 128, HTB = HALF * BK * 2, STAGE_BYTES = 8 * HTB, NXCD = 8, WGM = 4;
__device__ __forceinline__ int lds_byte(int r, int c) { const int st = (r >> 4) * 2 + (c >> 5), rr = r & 15, cc = c & 31, ob = rr * 64 + cc * 2; return st * 1024 + (ob ^ (((ob >> 9) & 1) << 5)); }
__device__ __forceinline__ void stage_rc(int b, int& R, int& C) { const int st = b / 1024, sb = b % 1024, swz = sb ^ (((sb >> 9) & 1) << 5); R = (st >> 1) * 16 + swz / 64; C = (st & 1) * 32 + (swz % 64) / 2; }
__device__ __forceinline__ int perm32(int rho) { const int n = rho >> 4, i = rho & 15; return 8 * (i >> 2) + 4 * n + (i & 3); }
struct Unit { int pm, pn, chunk; };
struct Gemm { const bf16_t* A; const bf16_t* Bt; int M, N, K; };
struct StaticOrder {
    int nM, nN, nwg, G, c, nt, nsplit;
    __device__ void init(int M, int N, int K, int G_, int c_, bool split_ctx) {
        nM = M / BM; nN = N / BM; nt = K / BK; G = G_; c = c_; nsplit = 0;
        if (split_ctx) { nM = 64; nsplit = 8 * (nt / 4); }
        nwg = nM * nN;
    }
    __device__ bool next(int i, Unit& u) const {
        const long L = (long)i * G + c;
        const int idx = (int)(L - nwg);
        const bool split = L >= nwg;
        int wgid = split ? 0 : (int)L; { const int q = nwg / NXCD, r = nwg % NXCD, xcd = wgid % NXCD, off = wgid / NXCD; wgid = (xcd < r ? xcd * (q + 1) : r * (q + 1) + (xcd - r) * q) + off; }
        const int nig = WGM * nN, gid = wgid / nig, fm = gid * WGM, gsz = (nM - fm) < WGM ? (nM - fm) : WGM;
        const int pm = fm + ((wgid % nig) % gsz), pn = (wgid % nig) / gsz;
        u.pm = split ? 64 + ((idx >> 2) & 1) : pm; u.pn = split ? (idx & 3) : pn; u.chunk = split ? (idx >> 3) : -1;
        return split ? idx < nsplit : true;
    }
};
template <class Epi>
__device__ __forceinline__ void gemm_phase(LAS unsigned char* lds, const Gemm g, const StaticOrder& S, const Epi& E) {
    const int tid = otid(), wid = __builtin_amdgcn_readfirstlane(tid >> 6), lane = tid & 63, wr = wid >> 2, wc = wid & 3, fr = lane & 15, fq = lane >> 4;
    const int K = g.K;
    unsigned voffA[2], voffB[2];
#pragma unroll
    for (int i = 0; i < 2; ++i) { int R, C; stage_rc(tid * 16 + i * 8192, R, C); const int Rb = (R & ~31) + perm32(R & 31);
        voffA[i] = (unsigned)(R * K + C) * 2u; voffB[i] = (unsigned)(Rb * K + C) * 2u; }
    const size_t kstep = (size_t)(BK * 2);
    const size_t hstep = (size_t)HALF * K * 2;
    const size_t tstep = 2 * hstep;
    const unsigned ldsw = (unsigned)wid * 1024u;
    const int aoff = lds_byte(wr * 64 + fr, fq * 8), boff = lds_byte(wc * 32 + fr, fq * 8);
#define PG8_SA(b, h) (((b) * 2 + (h)) * HTB)
#define PG8_SB(b, h) ((4 + (b) * 2 + (h)) * HTB)
#define PG8_STAGE(bufoff, gbase, voff) do { _Pragma("unroll") for (int _i = 0; _i < 2; ++_i) \
        __builtin_amdgcn_global_load_lds((const unsigned*)((const char*)(gbase) + (voff)[_i]), (LAS unsigned*)(lds + (bufoff) + ldsw + _i * 8192), 16, 0, 0); } while (0)
#define PG8_LDA(dst, b, h) do { _Pragma("unroll") for (int m = 0; m < 4; ++m) _Pragma("unroll") for (int k = 0; k < 2; ++k) dst[m][k] = *(const LAS bf16x8*)(lds + PG8_SA(b, h) + aoff + m * 2048 + k * 1024); } while (0)
#define PG8_LDB(dst, b, h) do { _Pragma("unroll") for (int n = 0; n < 2; ++n) _Pragma("unroll") for (int k = 0; k < 2; ++k) dst[n][k] = *(const LAS bf16x8*)(lds + PG8_SB(b, h) + boff + n * 2048 + k * 1024); } while (0)
#define PG8_MMA(ai, bj, At, Bt) do { __builtin_amdgcn_s_setprio(1); _Pragma("unroll") for (int m = 0; m < 4; ++m) _Pragma("unroll") for (int n = 0; n < 2; ++n) _Pragma("unroll") for (int k = 0; k < 2; ++k) \
        acc[ai][bj][m][n] = __builtin_amdgcn_mfma_f32_16x16x32_bf16(Bt[n][k], At[m][k], acc[ai][bj][m][n], 0, 0, 0); __builtin_amdgcn_s_setprio(0); } while (0)
#define PG8_WAIT_V(n) asm volatile("s_waitcnt vmcnt(" #n ")" ::: "memory")
#define PG8_WAIT_L(n) asm volatile("s_waitcnt lgkmcnt(" #n ")" ::: "memory")
#define PG8_BAR __builtin_amdgcn_s_barrier()
#define PG8_SCHED __builtin_amdgcn_sched_barrier(0)
    Unit cur, nxt; int ui = 0;
    if (!S.next(0, cur)) return;
    f32x4 acc[2][2][4][2];
#pragma unroll
    for (int a = 0; a < 2; ++a)
#pragma unroll
        for (int b = 0; b < 2; ++b)
#pragma unroll
            for (int m = 0; m < 4; ++m)
#pragma unroll
                for (int n = 0; n < 2; ++n) acc[a][b][m][n] = (f32x4){0.f, 0.f, 0.f, 0.f};
    bf16x8 At[4][2], B0[2][2], B1[2][2];
    const char* cA = (const char*)g.A + (size_t)cur.pm * tstep + (size_t)(cur.chunk < 0 ? 0 : cur.chunk * 4) * kstep; const char* cB = (const char*)g.Bt + (size_t)cur.pn * tstep + (size_t)(cur.chunk < 0 ? 0 : cur.chunk * 4) * kstep;
    PG8_STAGE(PG8_SB(0, 0), cB, voffB); PG8_STAGE(PG8_SA(0, 0), cA, voffA); PG8_STAGE(PG8_SB(0, 1), cB + hstep, voffB); PG8_STAGE(PG8_SA(0, 1), cA + hstep, voffA);
    if (wr == 1) PG8_BAR;
    PG8_WAIT_V(4); PG8_BAR;
    PG8_STAGE(PG8_SB(1, 0), cB + kstep, voffB); PG8_STAGE(PG8_SA(1, 0), cA + kstep, voffA); PG8_STAGE(PG8_SB(1, 1), cB + hstep + kstep, voffB);
    PG8_WAIT_V(6); PG8_BAR;
    for (;;) {
        const bool has_next = S.next(ui + 1, nxt);
        const char* nA = has_next ? (const char*)g.A + (size_t)nxt.pm * tstep + (size_t)(nxt.chunk < 0 ? 0 : nxt.chunk * 4) * kstep : cA; const char* nB = has_next ? (const char*)g.Bt + (size_t)nxt.pn * tstep + (size_t)(nxt.chunk < 0 ? 0 : nxt.chunk * 4) * kstep : cB;
        const int nt = cur.chunk < 0 ? S.nt : 4;
        for (int t = 0; t < nt; t += 2) {
            const bool last = (t == nt - 2);
            const char* a1 = cA + (size_t)(t + 1) * kstep;
            const char* a2 = last ? nA : cA + (size_t)(t + 2) * kstep; const char* b2 = last ? nB : cB + (size_t)(t + 2) * kstep;
            const char* a3 = a2 + kstep; const char* b3 = b2 + kstep;
            PG8_LDB(B0, 0, 0); PG8_SCHED; PG8_LDA(At, 0, 0); PG8_STAGE(PG8_SA(1, 1), a1 + hstep, voffA);
            PG8_WAIT_L(8); PG8_BAR; PG8_WAIT_L(0); PG8_MMA(0, 0, At, B0); PG8_BAR; PG8_SCHED;
            PG8_LDB(B1, 0, 1); PG8_STAGE(PG8_SB(0, 0), b2, voffB);
            PG8_BAR; PG8_WAIT_L(0); PG8_MMA(0, 1, At, B1); PG8_BAR;
            PG8_LDA(At, 0, 1); PG8_STAGE(PG8_SA(0, 0), a2, voffA);
            PG8_BAR; PG8_WAIT_L(0); PG8_MMA(1, 0, At, B0); PG8_BAR; PG8_SCHED;
            PG8_STAGE(PG8_SB(0, 1), b2 + hstep, voffB);
            PG8_WAIT_V(6); PG8_BAR; PG8_MMA(1, 1, At, B1); PG8_BAR;
            PG8_LDB(B0, 1, 0); PG8_SCHED; PG8_LDA(At, 1, 0); PG8_STAGE(PG8_SA(0, 1), a2 + hstep, voffA);
            PG8_WAIT_L(8); PG8_BAR; PG8_WAIT_L(0); PG8_MMA(0, 0, At, B0); PG8_BAR; PG8_SCHED;
            PG8_LDB(B1, 1, 1); PG8_STAGE(PG8_SB(1, 0), b3, voffB);
            PG8_BAR; PG8_WAIT_L(0); PG8_MMA(0, 1, At, B1); PG8_BAR;
            PG8_LDA(At, 1, 1); PG8_STAGE(PG8_SA(1, 0), a3, voffA);
            PG8_BAR; PG8_WAIT_L(0); PG8_MMA(1, 0, At, B0); PG8_BAR; PG8_SCHED;
            PG8_STAGE(PG8_SB(1, 1), b3 + hstep, voffB);
            PG8_WAIT_V(6); PG8_BAR; PG8_MMA(1, 1, At, B1); PG8_BAR;
        }
        E(acc, cur, wr, wc, fr, fq);
        if (!has_next) break;
#pragma unroll
        for (int a = 0; a < 2; ++a)
#pragma unroll
            for (int b = 0; b < 2; ++b)
#pragma unroll
                for (int m = 0; m < 4; ++m)
#pragma unroll
                    for (int n = 0; n < 2; ++n) acc[a][b][m][n] = (f32x4){0.f, 0.f, 0.f, 0.f};
        cur = nxt; cA = nA; cB = nB; ++ui;
    }
    PG8_WAIT_V(0);
    if (wr == 0) PG8_BAR;
    PG8_BAR;
#undef PG8_SA
#undef PG8_SB
#undef PG8_STAGE
#undef PG8_LDA
#undef PG8_LDB
#undef PG8_MMA
#undef PG8_WAIT_V
#undef PG8_WAIT_L
#undef PG8_BAR
#undef PG8_SCHED
}
}
using pg8::Unit;
typedef f32x4 AccT[2][2][4][2];

struct EpiSwiglu {
    bf16_t* O;
    __device__ __forceinline__ void operator()(const AccT& acc, const Unit& u, int wr, int wc, int fr, int fq) const {
        const int row0 = u.pm * 256 + wr * 64 + fr, col0 = u.pn * 128 + wc * 32 + 8 * fq;
#pragma unroll
        for (int ai = 0; ai < 2; ++ai)
#pragma unroll
            for (int m = 0; m < 4; ++m) {
                bf16_t* rowp = O + (size_t)(row0 + ai * 128 + m * 16) * DFF + col0;
                float v[8];
#pragma unroll
                for (int n = 0; n < 2; ++n)
#pragma unroll
                    for (int j = 0; j < 4; ++j) { const float g2 = acc[ai][0][m][n][j]; v[n * 4 + j] = (g2 * frcp(1.0f + fexp2(-g2))) * acc[ai][1][m][n][j]; }
                u32x4 w; w.x = cvt_pk_bf16(v[0], v[1]); w.y = cvt_pk_bf16(v[2], v[3]); w.z = cvt_pk_bf16(v[4], v[5]); w.w = cvt_pk_bf16(v[6], v[7]);
                *(u32x4*)rowp = w;
            }
    }
};
struct EpiResid {
    const float* xin_lat; const float* xin_ctx;
    char* ws; int gate_off; int mixout;
    __device__ __forceinline__ void operator()(const AccT& acc, const Unit& u, int wr, int wc, int fr, int fq) const {
        const int row0 = u.pm * 256 + wr * 64 + fr, col0 = u.pn * 256 + wc * 32 + 8 * fq;
        const int v = u.pm < 32 ? 0 : (u.pm < 64 ? 1 : 2);
        const float coef = mixout ? 1.0f : 0.5f;
        float* const xout = (float*)(ws + OFF_XS); float* const P = (float*)(ws + OFF_P);
        const float* gp = (const float*)(ws + OFF_MOD) + gate_off + v * 9216 + col0;
        f32x4 gv[2][2];
#pragma unroll
        for (int bj = 0; bj < 2; ++bj)
#pragma unroll
            for (int n = 0; n < 2; ++n) gv[bj][n] = *(const f32x4*)(gp + bj * 128 + 4 * n) * coef;
        if (u.chunk >= 0) {
            float* pb = P + (size_t)u.chunk * 512 * DM;
#pragma unroll
            for (int ai = 0; ai < 2; ++ai)
#pragma unroll
                for (int m = 0; m < 4; ++m) {
                    const size_t base = (size_t)(row0 - TL + ai * 128 + m * 16) * DM + col0;
#pragma unroll
                    for (int bj = 0; bj < 2; ++bj)
#pragma unroll
                        for (int n = 0; n < 2; ++n) *(f32x4*)(pb + base + bj * 128 + 4 * n) = gv[bj][n] * acc[ai][bj][m][n];
                }
            return;
        }
        const float* src = u.pm < 64 ? xin_lat : xin_ctx;
#pragma unroll
        for (int ai = 0; ai < 2; ++ai)
#pragma unroll
            for (int m = 0; m < 4; ++m) {
                const size_t base = (size_t)(row0 + ai * 128 + m * 16) * DM + col0;
#pragma unroll
                for (int bj = 0; bj < 2; ++bj)
#pragma unroll
                    for (int n = 0; n < 2; ++n) {
                        const f32x4 xv = *(const f32x4*)(src + base + bj * 128 + 4 * n);
                        *(f32x4*)(xout + base + bj * 128 + 4 * n) = xv + gv[bj][n] * acc[ai][bj][m][n];
                    }
            }
    }
};
__device__ __forceinline__ void store_bf16_tile(const AccT& acc, bf16_t* O, int ldo, int row0, int col0) {
#pragma unroll
    for (int ai = 0; ai < 2; ++ai)
#pragma unroll
        for (int m = 0; m < 4; ++m) {
            bf16_t* rowp = O + (size_t)(row0 + ai * 128 + m * 16) * ldo + col0;
#pragma unroll
            for (int bj = 0; bj < 2; ++bj) {
                const f32x4 v0 = acc[ai][bj][m][0], v1 = acc[ai][bj][m][1];
                u32x4 w; w.x = cvt_pk_bf16(v0[0], v0[1]); w.y = cvt_pk_bf16(v0[2], v0[3]); w.z = cvt_pk_bf16(v1[0], v1[1]); w.w = cvt_pk_bf16(v1[2], v1[3]);
                *(u32x4*)(rowp + bj * 128) = w;
            }
        }
}
struct EpiMixIn {
    int layer; char* ws; const float* qn; const float* kn;
    __device__ __forceinline__ void operator()(const AccT& acc, const Unit& u, int wr, int wc, int fr, int fq) const {
        const int row0 = u.pm * 256 + wr * 64 + fr, cw = wc * 32 + 8 * fq;
        const int lane = fq * 16 + fr;
        const bool l0 = layer == 0;
        const int qt0 = l0 ? 0 : 4, nqt = l0 ? 3 : 2, nkt = l0 ? 1 : 2;
        const int rel = u.pn - qt0;
        if (rel >= 0 && rel < nqt + 2 * nkt) {
            const bool isctx = u.pm >= 64;
            const int kind = rel < nqt ? 0 : (rel < nqt + nkt ? 1 : 2);
            const int head = (kind == 0 ? rel : (kind == 1 ? rel - nqt : rel - nqt - nkt)) * 4 + wc;
            const int nqh = l0 ? 12 : 8, nkv = l0 ? 4 : 8;
            if (kind == 2) {
                bf16_t* VT = (bf16_t*)(ws + (l0 ? A_VTALL : A_VTNA));
#pragma unroll
                for (int ai = 0; ai < 2; ++ai)
#pragma unroll
                    for (int m = 0; m < 4; ++m) {
                        const int r = row0 + ai * 128 + m * 16;
                        const int b = isctx ? (r - TL) >> 8 : r >> 13, n = isctx ? (r - TL) & 255 : r & 8191;
                        const int pos = isctx ? n : CTXL + n, ppos = (pos & ~12) | ((pos & 4) << 1) | ((pos & 8) >> 1);
                        bf16_t* dst = VT + (size_t)(b * nkv + head) * 64 * NKEY + ppos;
#pragma unroll
                        for (int bj = 0; bj < 2; ++bj)
#pragma unroll
                            for (int n2 = 0; n2 < 2; ++n2)
#pragma unroll
                                for (int j = 0; j < 4; ++j) dst[(size_t)(32 * bj + 8 * fq + 4 * n2 + j) * NKEY] = f2bf(acc[ai][bj][m][n2][j]);
                    }
            } else if (!(isctx && kind == 0 && !l0)) {
                f32x4 nw[2][2];
                if (l0) { const float* np = (kind == 0 ? qn : kn) + 8 * fq;
#pragma unroll
                    for (int bj = 0; bj < 2; ++bj)
#pragma unroll
                        for (int n2 = 0; n2 < 2; ++n2) nw[bj][n2] = *(const f32x4*)(np + 32 * bj + 4 * n2); }
                const float osc = kind == 0 ? QSCALE : 1.0f;
                float nmax = 0.f;
                const f32x4* cs = (const f32x4*)(ws + OFF_CS);
#pragma unroll
                for (int ai = 0; ai < 2; ++ai)
#pragma unroll
                    for (int m = 0; m < 4; ++m) {
                        const int r = row0 + ai * 128 + m * 16;
                        const int b = isctx ? (r - TL) >> 8 : r >> 13, n = isctx ? (r - TL) & 255 : r & 8191;
                        f32x4 x[2][2];
#pragma unroll
                        for (int bj = 0; bj < 2; ++bj)
#pragma unroll
                            for (int n2 = 0; n2 < 2; ++n2) x[bj][n2] = acc[ai][bj][m][n2];
                        if (!l0) {
                            float ss = 0.f;
#pragma unroll
                            for (int bj = 0; bj < 2; ++bj)
#pragma unroll
                                for (int n2 = 0; n2 < 2; ++n2) ss += x[bj][n2][0] * x[bj][n2][0] + x[bj][n2][1] * x[bj][n2][1] + x[bj][n2][2] * x[bj][n2][2] + x[bj][n2][3] * x[bj][n2][3];
                            ss += shx<16>(ss); ss += shx32(ss, lane);
                            nmax = fmaxf(nmax, ss);
                        }
                        if (l0) {
                            float ss = 0.f;
#pragma unroll
                            for (int bj = 0; bj < 2; ++bj)
#pragma unroll
                                for (int n2 = 0; n2 < 2; ++n2) ss += x[bj][n2][0] * x[bj][n2][0] + x[bj][n2][1] * x[bj][n2][1] + x[bj][n2][2] * x[bj][n2][2] + x[bj][n2][3] * x[bj][n2][3];
                            ss += shx<16>(ss); ss += shx32(ss, lane);
                            const float rs = rsqrtf(ss * (1.0f / 64.0f) + 1e-6f);
#pragma unroll
                            for (int bj = 0; bj < 2; ++bj)
#pragma unroll
                                for (int n2 = 0; n2 < 2; ++n2) x[bj][n2] = x[bj][n2] * rs * nw[bj][n2];
                            if (!isctx) {
                                const int pos = fq < 2 ? (n >> 6) : (n & 63);
                                const f32x4* cp = cs + (pos * 16 + ((8 * fq) & 15)) / 2;
#pragma unroll
                                for (int n2 = 0; n2 < 2; ++n2) {
                                    const f32x4 c01 = cp[n2 * 2], c23 = cp[n2 * 2 + 1];
                                    const float co[4] = {c01[0], c01[2], c23[0], c23[2]}, si[4] = {c01[1], c01[3], c23[1], c23[3]};
#pragma unroll
                                    for (int j = 0; j < 4; ++j) { const float x1 = x[0][n2][j], x2 = x[1][n2][j];
                                        x[0][n2][j] = x1 * co[j] - x2 * si[j]; x[1][n2][j] = x2 * co[j] + x1 * si[j]; }
                                }
                            }
                        }
                        bf16_t* dst;
                        if (kind == 0) dst = isctx ? (bf16_t*)(ws + A_QC) + ((size_t)(b * 12 + head) * CTXL + n) * 64
                                                   : (bf16_t*)(ws + (l0 ? A_Q : A_QN)) + ((size_t)(b * nqh + head) * SEQ + n) * 64;
                        else dst = (bf16_t*)(ws + (l0 ? A_KALL : A_KNA)) + ((size_t)(b * nkv + head) * NKEY + (isctx ? n : CTXL + n)) * 64;
#pragma unroll
                        for (int bj = 0; bj < 2; ++bj) {
                            u32x4 w; w.x = cvt_pk_bf16(x[bj][0][0] * osc, x[bj][0][1] * osc); w.y = cvt_pk_bf16(x[bj][0][2] * osc, x[bj][0][3] * osc);
                            w.z = cvt_pk_bf16(x[bj][1][0] * osc, x[bj][1][1] * osc); w.w = cvt_pk_bf16(x[bj][1][2] * osc, x[bj][1][3] * osc);
                            *(u32x4*)(dst + 32 * bj + 8 * fq) = w;
                        }
                    }
                if (!l0) {
                    nmax = fmaxf(nmax, shx<8>(nmax)); nmax = fmaxf(nmax, shx<4>(nmax)); nmax = fmaxf(nmax, shx<2>(nmax)); nmax = fmaxf(nmax, shx<1>(nmax));
                    if (lane == 0) (void)__hip_atomic_fetch_max((unsigned*)(ws + OFF_BAR) + (kind == 0 ? 3600 : 3664), __float_as_uint(nmax), __ATOMIC_RELAXED, __HIP_MEMORY_SCOPE_AGENT);
                }
            }
        } else if (l0) {
            float* Z = (float*)(ws + A_Z);
            const int col0 = (u.pn - 5) * 256 + cw;
#pragma unroll
            for (int ai = 0; ai < 2; ++ai)
#pragma unroll
                for (int m = 0; m < 4; ++m) {
                    float* rowp = Z + (size_t)(row0 + ai * 128 + m * 16) * 512 + col0;
#pragma unroll
                    for (int bj = 0; bj < 2; ++bj)
#pragma unroll
                        for (int n = 0; n < 2; ++n) *(f32x4*)(rowp + bj * 128 + 4 * n) = acc[ai][bj][m][n];
                }
        } else if (u.pm < 64) {
            bf16_t* U = (bf16_t*)(ws + A_U);
            const int col0 = u.pn * 128 + cw;
#pragma unroll
            for (int ai = 0; ai < 2; ++ai)
#pragma unroll
                for (int m = 0; m < 4; ++m) {
                    bf16_t* rowp = U + (size_t)(row0 + ai * 128 + m * 16) * 512 + col0;
                    float v[8];
#pragma unroll
                    for (int n = 0; n < 2; ++n)
#pragma unroll
                        for (int j = 0; j < 4; ++j) v[n * 4 + j] = acc[ai][0][m][n][j] * frcp(1.0f + fexp2(-acc[ai][1][m][n][j]));
                    u32x4 w; w.x = cvt_pk_bf16(v[0], v[1]); w.y = cvt_pk_bf16(v[2], v[3]); w.z = cvt_pk_bf16(v[4], v[5]); w.w = cvt_pk_bf16(v[6], v[7]);
                    *(u32x4*)rowp = w;
                }
        }
    }
};

__device__ __forceinline__ void conv_tile(float* tl, const float* src, int ld, int col0, int k0, bf16_t* dst, int K) {
    const int tid = otid();
    { const int r = tid >> 4, c4 = (tid & 15) * 4;
#pragma unroll
      for (int i = 0; i < 2; ++i) { const int kk = r + 32 * i; const f32x4 v = *(const f32x4*)(src + (size_t)(k0 + kk) * ld + col0 + c4);
          tl[kk * 65 + c4 + 0] = v[0]; tl[kk * 65 + c4 + 1] = v[1]; tl[kk * 65 + c4 + 2] = v[2]; tl[kk * 65 + c4 + 3] = v[3]; } }
    __syncthreads();
    { const int nn = tid >> 3, kc = (tid & 7) * 8; float v[8];
#pragma unroll
      for (int j = 0; j < 8; ++j) v[j] = tl[(kc + j) * 65 + nn];
      u32x4 w; w.x = cvt_pk_bf16(v[0], v[1]); w.y = cvt_pk_bf16(v[2], v[3]); w.z = cvt_pk_bf16(v[4], v[5]); w.w = cvt_pk_bf16(v[6], v[7]);
      *(u32x4*)(dst + (size_t)nn * K + kc) = w; }
    __syncthreads();
}

__device__ void transpose_tiles(PP pp, char* lds, int part, int first, int stride, int total) {
    const int tid = otid();
    float* fl = (float*)lds;
    const int wid = __builtin_amdgcn_readfirstlane(tid >> 6), lane = tid & 63;
    float* wl = fl + 3200 + wid * (64 * 33);
    for (int it4 = first; it4 * 4 < total; it4 += stride) {
        int u = it4 * 4 + (wid >> 1); const int nh = wid & 1;
        const bool valid = u < total;
        if (!valid) u = 0;
        int t = u;
        if (part == 11) t = u < 704 ? 5632 + u : (u < 1024 ? 8448 + (u - 704) : 1408 + (u - 1024));
        if (part == 12) t = u < 256 ? 8768 + u : 6336 + (u - 256);
        if (part == 13) t = u < 1408 ? 2816 + u : 7040 + (u - 1408);
        if (part == 14) t = u < 640 ? 9024 + u : 4224 + (u - 640);
        if (part == 15) t = u < 256 ? 9664 + u : 7744 + (u - 256);
        const float* src; int ld, col0, K, ntk; bf16_t* dst; int j; bool perm = false; float wsc = 1.0f;
        if (t < 5632) {
            const int w = t / 1408; t %= 1408; K = 1024; ntk = 16; j = t / ntk;
            const int pn = j >> 2, q = j & 3;
            src = (q < 2 ? pp->in[6] : pp->in[7]) + (size_t)w * 1024 * 2816; ld = 2816; col0 = pn * 128 + (q & 1) * 64;
            wsc = q < 2 ? LOG2E : 1.0f / LOG2E;
            dst = (bf16_t*)(pp->ws + OFF_W1T + w * SZ_W1T);
        } else if (t < 5632 + 2816) {
            t -= 5632; const int w = t / 704; t %= 704; K = 2816; ntk = 44; j = t / ntk;
            src = pp->in[8] + (size_t)w * 2816 * 1024; ld = 1024; col0 = j * 64;
            dst = (bf16_t*)(pp->ws + OFF_W2T + w * SZ_W2T);
        } else if (t < 8448 + 320) {
            t -= 8448; K = 1024; ntk = 16; j = t / ntk; src = pp->in[9]; ld = 1536; col0 = j * 64; dst = (bf16_t*)(pp->ws + OFF_ABIN); perm = true;
        } else if (t < 8768 + 256) {
            t -= 8768; K = 1024; ntk = 16; j = t / ntk; src = pp->in[10]; ld = 1024; col0 = j * 64; dst = (bf16_t*)(pp->ws + OFF_ABOUT);
        } else if (t < 9024 + 640) {
            t -= 9024; K = 1024; ntk = 16; j = t / ntk; src = pp->in[13]; ld = 2560;
            if (j < 16) { const int pn = j >> 2, q = j & 3; col0 = (q < 2 ? 0 : 512) + pn * 128 + (q & 1) * 64; if (q >= 2) wsc = LOG2E;   } else { col0 = j * 64; perm = true; }
            dst = (bf16_t*)(pp->ws + OFF_CDIN);
        } else {
            t -= 9664; K = 1024; ntk = 16; j = t / ntk; src = pp->in[14]; ld = 1024; col0 = j * 64; dst = (bf16_t*)(pp->ws + OFF_CDOUT);
        }
        const int k0 = (t % ntk) * 64;
        int scol = col0 + nh * 32;
        if (perm) { const int C = j * 2 + nh, c8 = C & 7; scol = ((C >> 3) * 8 + (c8 & 3) * 2 + (c8 >> 2)) * 32; }
        const float* sp = src + (size_t)(k0 + (lane >> 3)) * ld + scol + (lane & 7) * 4;
        f32x4 v[8];
#pragma unroll
        for (int i = 0; i < 8; ++i) v[i] = __builtin_nontemporal_load((const f32x4*)(sp + (size_t)(8 * i) * ld));
#pragma unroll
        for (int i = 0; i < 8; ++i) { float* q = wl + (8 * i + (lane >> 3)) * 33 + (lane & 7) * 4; q[0] = v[i][0] * wsc; q[1] = v[i][1] * wsc; q[2] = v[i][2] * wsc; q[3] = v[i][3] * wsc; }
        __syncthreads();
        { const int nn = lane >> 1, kh = (lane & 1) * 32;
          bf16_t* dp = dst + (size_t)(j * 64 + nh * 32 + nn) * K + k0 + kh;
#pragma unroll
          for (int c = 0; c < 4; ++c) { float f[8];
#pragma unroll
              for (int e = 0; e < 8; ++e) f[e] = wl[(kh + c * 8 + e) * 33 + nn];
              u32x4 w; w.x = cvt_pk_bf16(f[0], f[1]); w.y = cvt_pk_bf16(f[2], f[3]); w.z = cvt_pk_bf16(f[4], f[5]); w.w = cvt_pk_bf16(f[6], f[7]);
              if (valid) *(u32x4*)(dp + c * 8) = w; } }
        __syncthreads();
    }
}

__device__ void prep_phase(PP pp, char* lds) {
    const int tid = otid();
    float* fl = (float*)lds;
    for (int i = tid; i < 3072; i += 512) { const float c = i < 2048 ? pp->in[1][i] : pp->in[3][i - 2048]; fl[i] = c / (1.0f + expf(-c)); }
    float* ct = fl + 3072;
    float* st = fl + 3136;
    if (tid < 64) { float s, c; sincospif((float)tid / 32.0f, &s, &c); ct[tid] = c; st[tid] = s; }
    if (blockIdx.x == gridDim.x - 1) {
        f32x2* cst = (f32x2*)(pp->ws + OFF_CS);
        for (int i = tid; i < 2048; i += 512) { const int pos = i >> 4, jj = i & 15; const float inv = powf(10000.0f, -(float)jj / 16.0f); const float ang = (float)pos * inv;
            float sn, cn; sincosf(ang, &sn, &cn); cst[i] = (f32x2){cn, sn}; }
    }
    float* red = fl + 3200;
    float* tl = fl + 3200;
    __syncthreads();
    constexpr int N_GEMV = 288, N_Z = 64, N_TR = 9920;
    for (int item = blockIdx.x; item < N_GEMV + N_Z; item += gridDim.x) {
        if (item < N_GEMV) {
            const int layer = item / 144, n0 = (item % 144) * 64, cl = tid & 15, ks = tid >> 4;
            const float* W = pp->in[4] + ((size_t)layer * 1024 + ks * 32) * 9216 + n0 + cl * 4;
            float a[3][4];
#pragma unroll
            for (int v = 0; v < 3; ++v)
#pragma unroll
                for (int j = 0; j < 4; ++j) a[v][j] = 0.f;
#pragma unroll 8
            for (int kk = 0; kk < 32; ++kk) {
                const f32x4 w = __builtin_nontemporal_load((const f32x4*)(W + (size_t)kk * 9216));
#pragma unroll
                for (int v = 0; v < 3; ++v) { const float s = fl[v * 1024 + ks * 32 + kk];
#pragma unroll
                    for (int j = 0; j < 4; ++j) a[v][j] += s * w[j]; }
            }
#pragma unroll
            for (int v = 0; v < 3; ++v)
#pragma unroll
                for (int j = 0; j < 4; ++j) red[(ks * 16 + cl) * 12 + v * 4 + j] = a[v][j];
            __syncthreads();
            if (tid < 192) { const int c2 = tid / 12, vj = tid % 12, v = vj >> 2, j = vj & 3; float s = 0.f;
                for (int k2 = 0; k2 < 32; ++k2) s += red[(k2 * 16 + c2) * 12 + vj];
                const int n = n0 + c2 * 4 + j;
                ((float*)(pp->ws + OFF_MOD))[(layer * 3 + v) * 9216 + n] = s + pp->in[5][layer * 9216 + n]; }
            __syncthreads();
        } else if (item < N_GEMV + N_Z) {
            const int zi = item - N_GEMV, g = zi >> 4, k0 = (zi & 15) * 64;
            const float* src = pp->in[9];
            { const int r = tid >> 4, c4 = (tid & 15) * 4;
#pragma unroll
              for (int i = 0; i < 2; ++i) { const int kk = r + 32 * i; const f32x4 v = *(const f32x4*)(src + (size_t)(k0 + kk) * 1536 + 1280 + g * 64 + c4);
                  tl[kk * 65 + c4 + 0] = v[0]; tl[kk * 65 + c4 + 1] = v[1]; tl[kk * 65 + c4 + 2] = v[2]; tl[kk * 65 + c4 + 3] = v[3]; } }
            __syncthreads();
            const int kk = tid & 63, mp0 = tid >> 6;
            bf16_t* dst = (bf16_t*)(pp->ws + OFF_ABIN) + (size_t)(1280 + g * 128) * 1024 + k0 + kk;
            for (int e = 0; e < 16; ++e) {
                const int nl = mp0 * 16 + e, m = nl >> 1, part = nl & 1;
                float s = 0.f;
                for (int c = 0; c < 64; ++c) { const int idx = (m * c) & 63; const float t = part ? -st[idx] : ct[idx]; s += tl[kk * 65 + c] * t; }
                dst[(size_t)nl * 1024] = f2bf(s);
            }
            __syncthreads();
        }
    }
    if (gridDim.x == 256) transpose_tiles(pp, lds, 10, blockIdx.x, gridDim.x, 1408);
    else transpose_tiles(pp, lds, 0, blockIdx.x, gridDim.x, N_TR);
}

__device__ void norm_phase(const float* xlat, const float* xctx, int nrows, const float* modl, int si, int ci, bf16_t* h, int cmode, int nch, float* xs, const float* P) {
    const int tid = otid(), wid = tid >> 6, lane = tid & 63;
    const int nw = gridDim.x * 8;
    const int w0 = blockIdx.x * 8 + wid;
    const int nlat = nrows < TL ? nrows : TL, nctx = nrows - nlat;
    const int npre = (nctx > 0 && (w0 & 3) == 3) ? (nctx - (w0 >> 2) + (nw >> 2) - 1) / (nw >> 2) : 0;
    const int npair = (nlat - w0 + 2 * nw - 1) / (2 * nw);
    for (int itn = 0; itn < npre + (npair > 0 ? npair : 0); ++itn) {
        const bool pre = itn < npre;
        const int r0 = pre ? TL + (w0 >> 2) + itn * (nw >> 2) : w0 + (itn - npre) * 2 * nw;
        const int r1 = r0 + nw; const bool has1 = !pre && r1 < nlat;
        const int rr[2] = {r0, has1 ? r1 : r0};
        f32x4 x[2][4]; float ss[2] = {0.f, 0.f};
#pragma unroll
        for (int q = 0; q < 2; ++q) {
            const int r = rr[q];
            const float* src = r < TL ? xlat + (size_t)r * DM : xctx + (size_t)(r - TL) * DM;
#pragma unroll
            for (int i = 0; i < 4; ++i) x[q][i] = *(const f32x4*)(src + i * 256 + lane * 4);
        }
#pragma unroll
        for (int q = 0; q < 2; ++q) {
            const int r = rr[q];
            if (r >= TL && cmode != 0 && (q == 0 || has1)) {
                if (cmode == 2) {
                    for (int c = 0; c < nch; ++c) {
                        const float* pp = P + ((size_t)c * 512 + (r - TL)) * DM;
#pragma unroll
                        for (int i = 0; i < 4; ++i) x[q][i] += *(const f32x4*)(pp + i * 256 + lane * 4);
                    }
                }
#pragma unroll
                for (int i = 0; i < 4; ++i) *(f32x4*)(xs + (size_t)r * DM + i * 256 + lane * 4) = x[q][i];
            }
#pragma unroll
            for (int i = 0; i < 4; ++i) ss[q] += x[q][i][0] * x[q][i][0] + x[q][i][1] * x[q][i][1] + x[q][i][2] * x[q][i][2] + x[q][i][3] * x[q][i][3];
            ss[q] = wave_sum(ss[q], lane);
        }
#pragma unroll
        for (int q = 0; q < 2; ++q) {
            if (q == 1 && !has1) break;
            const int r = rr[q];
            const int v = r < SEQ ? 0 : (r < TL ? 1 : 2);
            const float* sh = modl + v * 9216 + si * 1024; const float* sc = modl + v * 9216 + ci * 1024;
            const float rs = rsqrtf(ss[q] * (1.0f / 1024.0f) + 1e-6f);
#pragma unroll
            for (int i = 0; i < 4; ++i) {
                const f32x4 s4 = *(const f32x4*)(sc + i * 256 + lane * 4), h4 = *(const f32x4*)(sh + i * 256 + lane * 4);
                const f32x4 y = x[q][i] * rs * (s4 + 1.0f) + h4;
                u32x2 w; w.x = cvt_pk_bf16(y[0], y[1]); w.y = cvt_pk_bf16(y[2], y[3]);
                *(u32x2*)(h + (size_t)r * DM + i * 256 + lane * 4) = w;
            }
        }
    }
}
__device__ void final_phase(const float* xs, const float* fn, float* out) {
    const int tid = otid(), wid = tid >> 6, lane = tid & 63;
    const int nw = gridDim.x * 8;
    for (int r0 = blockIdx.x * 8 + wid; r0 < TL; r0 += 2 * nw) {
        const int r1 = r0 + nw; const bool has1 = r1 < TL;
        const int rr[2] = {r0, has1 ? r1 : r0};
        f32x4 x[2][4]; float ss[2] = {0.f, 0.f};
#pragma unroll
        for (int q = 0; q < 2; ++q)
#pragma unroll
            for (int i = 0; i < 4; ++i) x[q][i] = *(const f32x4*)(xs + (size_t)rr[q] * DM + i * 256 + lane * 4);
#pragma unroll
        for (int q = 0; q < 2; ++q) {
#pragma unroll
            for (int i = 0; i < 4; ++i) ss[q] += x[q][i][0] * x[q][i][0] + x[q][i][1] * x[q][i][1] + x[q][i][2] * x[q][i][2] + x[q][i][3] * x[q][i][3];
            ss[q] = wave_sum(ss[q], lane);
        }
#pragma unroll
        for (int q = 0; q < 2; ++q) {
            if (q == 1 && !has1) break;
            const float rs = rsqrtf(ss[q] * (1.0f / 1024.0f) + 1e-6f);
#pragma unroll
            for (int i = 0; i < 4; ++i) { const f32x4 w4 = *(const f32x4*)(fn + i * 256 + lane * 4);
                __builtin_nontemporal_store(x[q][i] * rs * w4, (f32x4*)(out + (size_t)rr[q] * DM + i * 256 + lane * 4)); }
        }
    }
}

constexpr int AT_STAGE = 9216 + 9216, AT_RPB = 3 * AT_STAGE;
template <bool NOMAX>
__device__ __forceinline__ void attn_item(char* lds, const bf16_t* Qp, const bf16_t* Kp, const bf16_t* VTp, int ldv, int ntiles, bf16_t* Op, int ldo) {
    const int tid = otid(), wid = __builtin_amdgcn_readfirstlane(tid >> 6), lane = tid & 63;
    const int lr = lane & 31, lh = lane >> 5;
    bf16x8 qf[4];
#pragma unroll
    for (int kk = 0; kk < 4; ++kk) qf[kk] = *(const bf16x8*)(Qp + (size_t)(32 * wid + lr) * 64 + 16 * kk + 8 * lh);
    f32x16 o[2];
#pragma unroll
    for (int b = 0; b < 2; ++b)
#pragma unroll
        for (int i = 0; i < 16; ++i) o[b][i] = 0.f;
    float mrun = -1e30f, lrun = 0.f;
    u32x4 kreg, vreg;
    const bf16_t* kgp = Kp + tid * 8; const bf16_t* vgp = VTp + (size_t)(tid >> 3) * ldv + (tid & 7) * 8;
    const int kls = (tid >> 3) * 144 + (tid & 7) * 16, vls = 9216 + (tid >> 3) * 144 + (tid & 7) * 16;
    const int kfo = lr * 144 + lh * 16, vfo = 9216 + lr * 144 + lh * 16;
#define AT_SCHED __builtin_amdgcn_sched_barrier(0)
#define AT_GLOAD(t_) do { kreg = *(const u32x4*)(kgp + (size_t)(t_) * 4096); vreg = *(const u32x4*)(vgp + (t_) * 64); } while (0)
#define AT_LSTORE(s_) do { *(u32x4*)(lds + (s_) * AT_STAGE + kls) = kreg; *(u32x4*)(lds + (s_) * AT_STAGE + vls) = vreg; } while (0)
#define AT_KLOAD(KF, st_, kb_) do { const char* Ks_ = lds + (st_) * AT_STAGE + kfo + (kb_) * 4608; \
        _Pragma("unroll") for (int kk = 0; kk < 4; ++kk) KF[kk] = *(const bf16x8*)(Ks_ + kk * 32); } while (0)
#define AT_QKMMA(S, KF) do { \
        _Pragma("unroll") for (int i = 0; i < 16; ++i) S[i] = 0.f; \
        _Pragma("unroll") for (int kk = 0; kk < 4; ++kk) S = __builtin_amdgcn_mfma_f32_32x32x16_bf16(KF[kk], qf[kk], S, 0, 0, 0); } while (0)
#define AT_VLOAD(VF, st_, kb_) do { const char* Vs_ = lds + (st_) * AT_STAGE + vfo + (kb_) * 64; \
        _Pragma("unroll") for (int sl = 0; sl < 2; ++sl) _Pragma("unroll") for (int db = 0; db < 2; ++db) VF[sl][db] = *(const bf16x8*)(Vs_ + db * 4608 + sl * 32); } while (0)
#define AT_PVMMA(VF, PF) do { \
        _Pragma("unroll") for (int sl = 0; sl < 2; ++sl) _Pragma("unroll") for (int db = 0; db < 2; ++db) \
            o[db] = __builtin_amdgcn_mfma_f32_32x32x16_bf16(VF[sl][db], PF[sl], o[db], 0, 0, 0); } while (0)
#define AT_PACK(PF, S) do { _Pragma("unroll") for (int sl = 0; sl < 2; ++sl) { \
            u32x4 w_; w_.x = cvt_pk_bf16(S[8 * sl + 0], S[8 * sl + 1]); w_.y = cvt_pk_bf16(S[8 * sl + 2], S[8 * sl + 3]); \
            w_.z = cvt_pk_bf16(S[8 * sl + 4], S[8 * sl + 5]); w_.w = cvt_pk_bf16(S[8 * sl + 6], S[8 * sl + 7]); PF[sl] = __builtin_bit_cast(bf16x8, w_); } } while (0)
#define AT_STEP(SC, SN, T, HASN) do { const int t_ = (T); \
        constexpr bool hasn_ = HASN; \
        if (t_ + 2 < ntiles) AT_GLOAD(t_ + 2); \
        bf16x8 kfa_[4], kfb_[4]; bf16x8 vf0_[2][2], vf1_[2][2]; bf16x8 pf0_[2], pf1_[2]; \
        if (hasn_) AT_KLOAD(kfa_, sn, 0); \
        AT_SCHED; \
        if (hasn_) { AT_KLOAD(kfb_, sn, 1); AT_SCHED; AT_QKMMA(SN[0], kfa_); } \
        AT_VLOAD(vf0_, sc, 0); \
        AT_SCHED; \
        if (hasn_) AT_QKMMA(SN[1], kfb_); \
        AT_SCHED; \
        { \
            if constexpr (!NOMAX) { \
            float mx_ = max3f(SC[0][0], SC[1][0], SC[0][1]), my_ = max3f(SC[1][1], SC[0][2], SC[1][2]); \
            _Pragma("unroll") for (int i = 3; i < 15; i += 2) { mx_ = max3f(mx_, SC[0][i], SC[1][i]); my_ = max3f(my_, SC[0][i + 1], SC[1][i + 1]); } \
            mx_ = max3f(mx_, SC[0][15], SC[1][15]); mx_ = fmaxf(mx_, my_); \
            mx_ = fmaxf(mx_, shx32(mx_, lane)); \
            if (__builtin_amdgcn_ballot_w64(mx_ > mrun) != 0ull) { \
                const float mn_ = fmaxf(mrun, mx_); \
                const float alpha_ = fexp2(mrun - mn_); \
                mrun = mn_; \
                lrun *= alpha_; \
                _Pragma("unroll") for (int db = 0; db < 2; ++db) \
                _Pragma("unroll") for (int i = 0; i < 16; ++i) o[db][i] *= alpha_; \
            } \
            _Pragma("unroll") for (int kb = 0; kb < 2; ++kb) \
            _Pragma("unroll") for (int i = 0; i < 16; ++i) SC[kb][i] -= mrun; \
            } \
            float sum0_ = 0.f, sum1_ = 0.f, sum2_ = 0.f, sum3_ = 0.f; \
            _Pragma("unroll") for (int i = 0; i < 16; i += 4) { SC[0][i] = fexp2(SC[0][i]); SC[0][i + 1] = fexp2(SC[0][i + 1]); SC[0][i + 2] = fexp2(SC[0][i + 2]); SC[0][i + 3] = fexp2(SC[0][i + 3]); \
                sum0_ += SC[0][i]; sum1_ += SC[0][i + 1]; sum2_ += SC[0][i + 2]; sum3_ += SC[0][i + 3]; } \
            AT_PACK(pf0_, SC[0]); \
            AT_SCHED; \
            AT_VLOAD(vf1_, sc, 1); \
            AT_PVMMA(vf0_, pf0_); \
            AT_SCHED; \
            _Pragma("unroll") for (int i = 0; i < 16; i += 4) { SC[1][i] = fexp2(SC[1][i]); SC[1][i + 1] = fexp2(SC[1][i + 1]); SC[1][i + 2] = fexp2(SC[1][i + 2]); SC[1][i + 3] = fexp2(SC[1][i + 3]); \
                sum0_ += SC[1][i]; sum1_ += SC[1][i + 1]; sum2_ += SC[1][i + 2]; sum3_ += SC[1][i + 3]; } \
            lrun += (sum0_ + sum1_) + (sum2_ + sum3_); \
            AT_PACK(pf1_, SC[1]); \
            AT_SCHED; \
            AT_PVMMA(vf1_, pf1_); \
        } \
        if (t_ + 2 < ntiles) AT_LSTORE(sp); \
        { const int tmp_ = sc; sc = sn; sn = sp; sp = tmp_; } \
        __syncthreads(); } while (0)
    int sc = 0, sn = 1, sp = 2;
    AT_GLOAD(0); AT_LSTORE(0);
    if (ntiles > 1) { AT_GLOAD(1); AT_LSTORE(1); }
    __syncthreads();
    f32x16 sa[2], sb[2];
    { bf16x8 kfa_[4], kfb_[4]; AT_KLOAD(kfa_, 0, 0); AT_KLOAD(kfb_, 0, 1); AT_QKMMA(sa[0], kfa_); AT_QKMMA(sa[1], kfb_); }
    for (int t = 0; t < ntiles - 2; t += 2) {
        AT_STEP(sa, sb, t, true);
        AT_STEP(sb, sa, t + 1, true);
    }
    AT_STEP(sa, sb, ntiles - 2, true);
    AT_STEP(sb, sa, ntiles - 1, false);
#undef AT_GLOAD
#undef AT_LSTORE
#undef AT_KLOAD
#undef AT_QKMMA
#undef AT_VLOAD
#undef AT_PVMMA
#undef AT_PACK
#undef AT_SCHED
#undef AT_STEP
    {
        float l = lrun + shx32(lrun, lane);
        const float inv = 1.0f / l;
        bf16_t* orow = Op + (size_t)(32 * wid + lr) * ldo;
#pragma unroll
        for (int db = 0; db < 2; ++db)
#pragma unroll
            for (int i4 = 0; i4 < 4; ++i4) {
                u32x2 w; w.x = cvt_pk_bf16(o[db][i4 * 4 + 0] * inv, o[db][i4 * 4 + 1] * inv); w.y = cvt_pk_bf16(o[db][i4 * 4 + 2] * inv, o[db][i4 * 4 + 3] * inv);
                *(u32x2*)(orow + 32 * db + 8 * i4 + 4 * lh) = w;
            }
    }
}

template <bool NA, bool NOMAX>
__device__ __forceinline__ void attn_item_na(char* lds, const bf16_t* Qp, const bf16_t* Kp, const bf16_t* VTp, int ldv, int ntiles, int toff,
                                          bf16_t* Op, int ldo, int na_r0, int na_rs0) {
    const int tid = otid(), wid = __builtin_amdgcn_readfirstlane(tid >> 6), lane = tid & 63;
    const int lr = lane & 31, lh = lane >> 5;
    const float* rpbs = (const float*)(lds + AT_RPB);
    bf16x8 qf[4];
#pragma unroll
    for (int kk = 0; kk < 4; ++kk) qf[kk] = *(const bf16x8*)(Qp + (size_t)(32 * wid + lr) * 64 + 16 * kk + 8 * lh);
    f32x16 o[2];
#pragma unroll
    for (int b = 0; b < 2; ++b)
#pragma unroll
        for (int i = 0; i < 16; ++i) o[b][i] = 0.f;
    float mrun = -1e30f, lrun = 0.f;
    u32x4 kreg, vreg;
    const int na_r = na_r0 + (wid >> 1);
    const int na_rs = min(max(na_r - 4, 0), 120);
    const int na_c = 32 * (wid & 1) + lr, na_cst = min(max(na_c - 8, 0), 48);
    float madd[2][16];
    if (NA) {
#pragma unroll
        for (int kb = 0; kb < 2; ++kb)
#pragma unroll
            for (int i = 0; i < 16; ++i) { const int kc = 32 * kb + (i & 3) + 8 * (i >> 2) + 4 * lh; madd[kb][i] = (unsigned)(kc - na_cst) < 16u ? 0.f : -1e30f; }
    }
#define AT_GLOAD(t_) do { const int kt_ = (t_) < 4 ? (t_) : (t_) + toff; \
        kreg = *(const u32x4*)(Kp + (size_t)kt_ * 4096 + tid * 8); vreg = *(const u32x4*)(VTp + (size_t)(tid >> 3) * ldv + kt_ * 64 + (tid & 7) * 8); } while (0)
#define AT_LSTORE(s_) do { *(u32x4*)(lds + (s_) * AT_STAGE + (tid >> 3) * 144 + (tid & 7) * 16) = kreg; *(u32x4*)(lds + (s_) * AT_STAGE + 9216 + (tid >> 3) * 144 + (tid & 7) * 16) = vreg; } while (0)
    AT_GLOAD(0); AT_LSTORE(0);
    __syncthreads();
    for (int t = 0; t < ntiles; ++t) {
        if (t + 1 < ntiles) AT_GLOAD(t + 1);
        bool active = true;
        int kr = 0;
        if (NA) { kr = na_rs0 + t - 4; if (t >= 4 && (kr < na_rs || kr >= na_rs + 8)) active = false; }
        if (active) {
            const char* Ks = lds + (t & 1) * AT_STAGE; const char* Vs = Ks + 9216;
            f32x16 s[2];
#pragma unroll
            for (int kb = 0; kb < 2; ++kb) {
#pragma unroll
                for (int i = 0; i < 16; ++i) s[kb][i] = 0.f;
#pragma unroll
                for (int kk = 0; kk < 4; ++kk) {
                    const bf16x8 kf = *(const bf16x8*)(Ks + (32 * kb + lr) * 144 + (16 * kk + 8 * lh) * 2);
                    s[kb] = __builtin_amdgcn_mfma_f32_32x32x16_bf16(kf, qf[kk], s[kb], 0, 0, 0);
                }
            }
            if (NA && t >= 4) {
                const float* rb = rpbs + 64 + (kr - na_r + 7) * 31 + 15 - na_c + 4 * lh;
#pragma unroll
                for (int kb = 0; kb < 2; ++kb)
#pragma unroll
                    for (int i = 0; i < 16; ++i) s[kb][i] = (s[kb][i] + rb[32 * kb + (i & 3) + 8 * (i >> 2)]) + madd[kb][i];
            }
            if constexpr (NOMAX) {
                float sum = 0.f;
#pragma unroll
                for (int kb = 0; kb < 2; ++kb)
#pragma unroll
                    for (int i = 0; i < 16; ++i) { s[kb][i] = fexp2(s[kb][i]); sum += s[kb][i]; }
                lrun += sum;
            } else {
                float mx = s[0][0];
    #pragma unroll
                for (int i = 1; i < 16; ++i) mx = fmaxf(mx, s[0][i]);
    #pragma unroll
                for (int i = 0; i < 16; ++i) mx = fmaxf(mx, s[1][i]);
                mx = fmaxf(mx, shx32(mx, lane));
                const float mn = fmaxf(mrun, mx), alpha = fexp2(mrun - mn);
                mrun = mn;
                float sum = 0.f;
    #pragma unroll
                for (int kb = 0; kb < 2; ++kb)
    #pragma unroll
                    for (int i = 0; i < 16; ++i) { s[kb][i] = fexp2(s[kb][i] - mn); sum += s[kb][i]; }
                lrun = lrun * alpha + sum;
    #pragma unroll
                for (int db = 0; db < 2; ++db)
    #pragma unroll
                    for (int i = 0; i < 16; ++i) o[db][i] *= alpha;
            }
#pragma unroll
            for (int kb = 0; kb < 2; ++kb)
#pragma unroll
                for (int sl = 0; sl < 2; ++sl) {
                    u32x4 w; w.x = cvt_pk_bf16(s[kb][8 * sl + 0], s[kb][8 * sl + 1]); w.y = cvt_pk_bf16(s[kb][8 * sl + 2], s[kb][8 * sl + 3]);
                    w.z = cvt_pk_bf16(s[kb][8 * sl + 4], s[kb][8 * sl + 5]); w.w = cvt_pk_bf16(s[kb][8 * sl + 6], s[kb][8 * sl + 7]);
                    const bf16x8 pf = __builtin_bit_cast(bf16x8, w);
#pragma unroll
                    for (int db = 0; db < 2; ++db) {
                        const bf16x8 vf = *(const bf16x8*)(Vs + (32 * db + lr) * 144 + (32 * kb + 16 * sl + 8 * lh) * 2);
                        o[db] = __builtin_amdgcn_mfma_f32_32x32x16_bf16(vf, pf, o[db], 0, 0, 0);
                    }
                }
        }
        if (t + 1 < ntiles) AT_LSTORE((t + 1) & 1);
        __syncthreads();
    }
#undef AT_GLOAD
#undef AT_LSTORE
    {
        float l = lrun + shx32(lrun, lane);
        const float inv = 1.0f / l;
        bf16_t* orow = Op + (size_t)(32 * wid + lr) * ldo;
#pragma unroll
        for (int db = 0; db < 2; ++db)
#pragma unroll
            for (int i4 = 0; i4 < 4; ++i4) {
                u32x2 w; w.x = cvt_pk_bf16(o[db][i4 * 4 + 0] * inv, o[db][i4 * 4 + 1] * inv); w.y = cvt_pk_bf16(o[db][i4 * 4 + 2] * inv, o[db][i4 * 4 + 3] * inv);
                *(u32x2*)(orow + 32 * db + 8 * i4 + 4 * lh) = w;
            }
    }
}

__device__ void fft_item(char* lds, const float* Z, int row0, int N, int logN, int col, bf16_t* cat, float scale) {
    const int tid = otid();
    f32x2* x = (f32x2*)lds;
    const f32x2* tw = (const f32x2*)(lds + 65536);
    for (int i = tid; i < N; i += 512) x[i] = *(const f32x2*)(Z + (size_t)(row0 + i) * 512 + col * 2);
    __syncthreads();
    for (int lh = logN - 1; lh >= 0; --lh) {
        const int half = 1 << lh, twsh = 12 - lh;
        if (N == 8192) {
            f32x2 a[8], b[8], w[8]; int ia[8];
#pragma unroll
            for (int u = 0; u < 8; ++u) { const int j = tid + 512 * u, pos = j & (half - 1); ia[u] = ((j >> lh) << (lh + 1)) + pos; a[u] = x[ia[u]]; b[u] = x[ia[u] + half]; w[u] = tw[pos << twsh]; }
#pragma unroll
            for (int u = 0; u < 8; ++u) { const f32x2 d = a[u] - b[u]; x[ia[u]] = a[u] + b[u]; x[ia[u] + half] = (f32x2){d.x * w[u].x - d.y * w[u].y, d.x * w[u].y + d.y * w[u].x}; }
        } else {
            for (int j = tid; j < (N >> 1); j += 512) {
                const int pos = j & (half - 1), i0 = ((j >> lh) << (lh + 1)) + pos, i1 = i0 + half;
                const f32x2 a = x[i0], b = x[i1], w = tw[pos << twsh];
                const f32x2 d = a - b;
                x[i0] = a + b;
                x[i1] = (f32x2){d.x * w.x - d.y * w.y, d.x * w.y + d.y * w.x};
            }
        }
        __syncthreads();
    }
    for (int i = tid; i < N; i += 512) { const int k = (int)(__brev((unsigned)i) >> (32 - logN)); cat[(size_t)(row0 + k) * DM + 768 + col] = f2bf(x[i].x * scale); }
    __syncthreads();
}

__device__ void mix_ab_phase(PP pp, char* lds) {
    const int tid = otid(), bid = blockIdx.x;
    char* ws = pp->ws;
    bf16_t* cat = (bf16_t*)(ws + OFF_H);
    const float* Z = (const float*)(ws + A_Z);
    { f32x2* tw = (f32x2*)(lds + 65536);
      for (int j = tid; j < 4096; j += 512) { float s, c; sincospif((float)j / 4096.0f, &s, &c); tw[j] = (f32x2){c, -s}; } }
    __syncthreads();
    for (int ci = bid; ci < 1024; ci += gridDim.x) {
        int idx = ci & 511; const bool isctx = ci >= 512;
        if (gridDim.x == 256) idx = (bid & 7) * 64 + (bid >> 3) * 2 + ((ci >> 8) & 1);
        const int b = idx >> 8, col = idx & 255;
        if (!isctx) fft_item(lds, Z, b * SEQ, SEQ, 13, col, cat, 0.001381067932f  );
        else fft_item(lds, Z, TL + b * CTXL, CTXL, 8, col, cat, 0.0078125f  );
    }
    bool nomax;
    { float mq = 0.f, mk = 0.f;
      for (int i = 0; i < 64; ++i) { mq = fmaxf(mq, fabsf(pp->in[11][i])); mk = fmaxf(mk, fabsf(pp->in[12][i])); }
      const float bound = 64.0f * mq * mk * QSCALE;
      nomax = bound < 64.0f; }
    const bf16_t* Q = (const bf16_t*)(ws + A_Q); const bf16_t* QC = (const bf16_t*)(ws + A_QC);
    const bf16_t* Kall = (const bf16_t*)(ws + A_KALL); const bf16_t* VT = (const bf16_t*)(ws + A_VTALL);
    for (int it = bid; it < 24; it += gridDim.x) {
        const int b = it / 12, h = it % 12, kvh = h / 3;
        if (nomax) attn_item<true>(lds, QC + (size_t)(b * 12 + h) * CTXL * 64, Kall + (size_t)(b * 4 + kvh) * NKEY * 64, VT + (size_t)(b * 4 + kvh) * 64 * NKEY, NKEY, 4,
                  cat + (size_t)(TL + b * CTXL) * DM + h * 64, DM);
        else attn_item<false>(lds, QC + (size_t)(b * 12 + h) * CTXL * 64, Kall + (size_t)(b * 4 + kvh) * NKEY * 64, VT + (size_t)(b * 4 + kvh) * 64 * NKEY, NKEY, 4,
                  cat + (size_t)(TL + b * CTXL) * DM + h * 64, DM);
    }
    for (int e = bid; e < 768; e += gridDim.x) {
        int g, qb, bk;
        if (gridDim.x == 256) {
            bk = bid & 7;
            const int idx = (bid >> 3) * 3 + (e >> 8); g = idx % 3; qb = idx / 3;
        } else { g = e % 3; const int r1 = e / 3; qb = r1 & 31; bk = r1 >> 5; }
        const int b = bk >> 2, kvh = bk & 3, h = kvh * 3 + g;
        if (nomax) attn_item<true>(lds, Q + ((size_t)(b * 12 + h) * SEQ + qb * 256) * 64, Kall + (size_t)bk * NKEY * 64, VT + (size_t)bk * 64 * NKEY, NKEY, 132,
                  cat + (size_t)(b * SEQ + qb * 256) * DM + h * 64, DM);
        else attn_item<false>(lds, Q + ((size_t)(b * 12 + h) * SEQ + qb * 256) * 64, Kall + (size_t)bk * NKEY * 64, VT + (size_t)bk * 64 * NKEY, NKEY, 132,
                  cat + (size_t)(b * SEQ + qb * 256) * DM + h * 64, DM);
    }
}

__device__ void conv_item(PP pp, char* lds, int item) {
    const int tid = otid(), wid = tid >> 6, lane = tid & 63;
    const bf16_t* U = (const bf16_t*)(pp->ws + A_U);
    bf16_t* cat2 = (bf16_t*)(pp->ws + OFF_H);
    bf16_t* ut = (bf16_t*)lds;
    float* yt = (float*)(lds + 63488);
    const int t0 = item * 32, b = t0 >> 13, n0 = t0 & 8191;
    for (int c = tid; c < 62 * 64; c += 512) {
        const int rr = c >> 6, part = c & 63, n = n0 - 15 + rr;
        u32x4 v = (u32x4){0u, 0u, 0u, 0u};
        if (n >= 0 && n < SEQ) v = *(const u32x4*)(U + ((size_t)(b * SEQ + n)) * 512 + part * 8);
        *(u32x4*)(ut + rr * 512 + part * 8) = v;
    }
    float w[31];
#pragma unroll
    for (int j = 0; j < 31; ++j) w[j] = pp->in[15][j * 512 + tid];
    const float bias = pp->in[16][tid];
    __syncthreads();
#pragma unroll 1
    for (int tg = 0; tg < 4; ++tg) {
        float y[8];
#pragma unroll
        for (int t = 0; t < 8; ++t) y[t] = bias;
#pragma unroll
        for (int i = 0; i < 38; ++i) {
            const float uv = bf2f(ut[(tg * 8 + i) * 512 + tid]);
#pragma unroll
            for (int t = 0; t < 8; ++t) { const int j = i - t; if (j >= 0 && j < 31) y[t] += uv * w[j]; }
        }
#pragma unroll
        for (int t = 0; t < 8; ++t) yt[(tg * 8 + t) * 516 + tid] = y[t];
    }
    __syncthreads();
    const float* lw = pp->in[17]; const float* lb = pp->in[18];
#pragma unroll 1
    for (int q = 0; q < 4; ++q) {
        const int tok = wid * 4 + q;
        const f32x4 a = *(const f32x4*)(yt + tok * 516 + lane * 8), c = *(const f32x4*)(yt + tok * 516 + lane * 8 + 4);
        float s = a[0] + a[1] + a[2] + a[3] + c[0] + c[1] + c[2] + c[3];
        s = wave_sum(s, lane);
        const float mu = s * (1.0f / 512.0f);
        const f32x4 da = a - mu, dc = c - mu;
        float vs = da[0] * da[0] + da[1] * da[1] + da[2] * da[2] + da[3] * da[3] + dc[0] * dc[0] + dc[1] * dc[1] + dc[2] * dc[2] + dc[3] * dc[3];
        vs = wave_sum(vs, lane);
        const float rs = rsqrtf(vs * (1.0f / 512.0f) + 1e-6f);
        const f32x4 w0 = *(const f32x4*)(lw + lane * 8), w1 = *(const f32x4*)(lw + lane * 8 + 4), b0 = *(const f32x4*)(lb + lane * 8), b1 = *(const f32x4*)(lb + lane * 8 + 4);
        f32x4 y0 = da * rs * w0 + b0, y1 = dc * rs * w1 + b1;
#pragma unroll
        for (int j = 0; j < 4; ++j) { y0[j] = siluf_(y0[j]); y1[j] = siluf_(y1[j]); }
        u32x4 o; o.x = cvt_pk_bf16(y0[0], y0[1]); o.y = cvt_pk_bf16(y0[2], y0[3]); o.z = cvt_pk_bf16(y1[0], y1[1]); o.w = cvt_pk_bf16(y1[2], y1[3]);
        *(u32x4*)(cat2 + (size_t)(t0 + tok) * DM + lane * 8) = o;
    }
    __syncthreads();
}
__device__ void mix_cd_phase(PP pp, char* lds) {
    const int tid = otid(), bid = blockIdx.x;
    char* ws = pp->ws;
    for (int it = bid; it < 512; it += gridDim.x) conv_item(pp, lds, it);
    bool nomax;
    { float bm = 0.f;
      for (int i = tid; i < 8 * 527; i += 512) bm = fmaxf(bm, fabsf(pp->in[19][i]));
      bm = fmaxf(bm, shx32(bm, tid & 63)); bm = fmaxf(bm, shx<16>(bm)); bm = fmaxf(bm, shx<8>(bm)); bm = fmaxf(bm, shx<4>(bm)); bm = fmaxf(bm, shx<2>(bm)); bm = fmaxf(bm, shx<1>(bm));
      float* red = (float*)(lds + 130048);
      if ((tid & 63) == 0) red[tid >> 6] = bm;
      __syncthreads();
      float bb = red[0];
      for (int i = 1; i < 8; ++i) bb = fmaxf(bb, red[i]);
      const unsigned* bw = (const unsigned*)(ws + OFF_BAR);
      const float q2 = __uint_as_float(bw[3600]), k2 = __uint_as_float(bw[3664]);
      const float bound = sqrtf(q2) * sqrtf(k2) * QSCALE * 1.02f + bb * LOG2E;
      nomax = bound < 64.0f;
      __syncthreads(); }
    const bf16_t* QN = (const bf16_t*)(ws + A_QN); const bf16_t* Kna = (const bf16_t*)(ws + A_KNA); const bf16_t* VT = (const bf16_t*)(ws + A_VTNA);
    bf16_t* cat2 = (bf16_t*)(ws + OFF_H);
    for (int it = bid; it < 512; it += gridDim.x) {
        int h, rb, b;
        if (gridDim.x == 256) { const int bh = (bid & 7) + 8 * (it >> 8); b = bh >> 3; h = bh & 7; rb = bid >> 3; }
        else { h = it & 7; rb = (it >> 3) & 31; b = it >> 8; }
        const int r0 = rb * 4;
        const int rs0 = min(max(r0 - 4, 0), 120), rs3 = min(max(r0 + 3 - 4, 0), 120);
        const int ntiles = 4 + (rs3 + 8 - rs0);
        float* rpbs = (float*)(lds + AT_RPB);
        for (int i = tid; i < 64 + 527 + 64; i += 512) rpbs[i] = (i >= 64 && i < 64 + 527) ? pp->in[19][h * 527 + i - 64] * LOG2E : 0.f;
        const bf16_t* qp = QN + ((size_t)(b * 8 + h) * SEQ + r0 * 64) * 64; const bf16_t* kp = Kna + (size_t)(b * 8 + h) * NKEY * 64; const bf16_t* vp = VT + (size_t)(b * 8 + h) * 64 * NKEY;
        bf16_t* op = cat2 + (size_t)(b * SEQ + r0 * 64) * DM + 512 + h * 64;
        if (nomax) attn_item_na<true, true>(lds, qp, kp, vp, NKEY, ntiles, rs0, op, DM, r0, rs0);
        else attn_item_na<true, false>(lds, qp, kp, vp, NKEY, ntiles, rs0, op, DM, r0, rs0);
    }
}

constexpr int NSTEPS = 22;
#define ST(op, a0, a1) ((op) | ((a0) << 4) | ((a1) << 8))
#define STN(a0, a1, nch) (1 | ((a0) << 4) | ((a1) << 8) | ((nch) << 12))
__constant__ int STEP_TAB[NSTEPS] = {
    ST(0, 0, 0),
    STN(0, 1, 0), ST(2, 0, 0), ST(3, 0, 2), STN(3, 4, 11), ST(4, 0, 0), ST(6, 0, 0), ST(3, 2, 5), STN(6, 7, 4), ST(2, 1, 0), ST(3, 1, 8),
    STN(0, 1, 11), ST(2, 0, 0), ST(3, 0, 2), STN(3, 4, 11), ST(4, 0, 0), ST(6, 0, 0), ST(3, 2, 5), STN(6, 7, 0), ST(2, 1, 0), ST(3, 1, 8),
    ST(7, 0, 0)};
__global__ void __launch_bounds__(512, 2) fwd_megakernel(Params p, int s0, int s1) {
    extern __shared__ __attribute__((aligned(16))) unsigned char shm[];
    char* lds = (char*)shm;
    volatile LAS unsigned* bst = (volatile LAS unsigned*)((LAS unsigned char*)shm + 131072);
    if (threadIdx.x == 0) { bst[0] = 0u; bst[1] = 0u; bst[2] = 0u; bst[3] = 0u; }
    __syncthreads();
    XcdBarrier gbar;
    { PP pp0 = (PP)__builtin_amdgcn_kernarg_segment_ptr(); gbar = xcd_barrier_post((unsigned*)(pp0->ws + OFF_BAR), bst); }
    if (s1 > 1000) cg::this_grid().sync();
#ifndef DUP_MASK
#define DUP_MASK 0u
#endif
    for (int sidx = s0; sidx < s1 + (int)__builtin_popcount(DUP_MASK); ++sidx) {
        if (sidx > s0) xcd_barrier(gbar);
        int step = sidx;
        if (DUP_MASK != 0u) { int acc = 0; step = 0; for (int q = 0; q < NSTEPS; ++q) { const int reps = 1 + (int)((DUP_MASK >> q) & 1u); if (sidx >= acc && sidx < acc + reps) step = q; acc += reps; } }
        PP pp = (PP)__builtin_amdgcn_kernarg_segment_ptr();
        asm volatile("" : "+s"(pp));
        char* ws = pp->ws;
        float* xs = (float*)(ws + OFF_XS);
        bf16_t* hbuf = (bf16_t*)(ws + OFF_H);
        bf16_t* act = (bf16_t*)(ws + OFF_A);
        const float* mod = (const float*)(ws + OFF_MOD);
        const int layer = step >= 11 ? 1 : 0;
        const float* modl = mod + layer * 3 * 9216;
        const int code = STEP_TAB[step];
        const int op = code & 15, a0 = (code >> 4) & 15, a1 = (code >> 8) & 15, nch = (code >> 12) & 15;
        const bool tail = step >= 17;
        const int Mrows = tail ? TL : TT;
        if (op == 0) prep_phase(pp, lds);
        else if (op == 1) {
            const bool first = step == 1;
            norm_phase(first ? pp->in[0] : xs, first ? pp->in[2] : xs + (size_t)TL * DM, Mrows, modl, a0, a1, hbuf, first ? 1 : (nch ? 2 : 0), nch, xs, (const float*)(ws + OFF_P));
        } else if (op == 2) {
            pg8::Gemm g{hbuf, (const bf16_t*)(ws + OFF_W1T + (size_t)(layer * 2 + a0) * SZ_W1T), Mrows, 5632, 1024};
            pg8::StaticOrder S; S.init(g.M, g.N, g.K, (int)gridDim.x, (int)blockIdx.x, false);
            EpiSwiglu E{act};
            pg8::gemm_phase(( LAS unsigned char*)shm, g, S, E);
            if (gridDim.x == 256 && blockIdx.x >= 172) {
                if (step == 2) transpose_tiles(pp, lds, 11, (int)blockIdx.x - 172, 84, 2432);
                if (step == 9) transpose_tiles(pp, lds, 13, (int)blockIdx.x - 172, 84, 2112);
                if (step == 12) transpose_tiles(pp, lds, 14, (int)blockIdx.x - 172, 84, 2048);
            }
        } else if (op == 3) {
            const bool mixout = a0 == 2, first = step == 3;
            const bf16_t* Bw = (const bf16_t*)(ws + (mixout ? (layer == 0 ? OFF_ABOUT : OFF_CDOUT) : OFF_W2T + (size_t)(layer * 2 + a0) * SZ_W2T));
            const pg8::Gemm g{mixout ? hbuf   : act, Bw, Mrows, 1024, mixout ? 1024 : 2816};
            const float* xl = first ? pp->in[0] : xs; const float* xc = first ? pp->in[2] - (size_t)TL * DM : xs;
            const EpiResid E{xl, xc, ws, layer * 3 * 9216 + a1 * 1024, mixout ? 1 : 0};
            pg8::StaticOrder S; S.init(g.M, g.N, g.K, (int)gridDim.x, (int)blockIdx.x, !tail);
            pg8::gemm_phase((LAS unsigned char*)shm, g, S, E);
        } else if (op == 4) {
            const bool l0 = layer == 0;
            pg8::Gemm g{hbuf, (const bf16_t*)(ws + (l0 ? OFF_ABIN : OFF_CDIN)), TT, l0 ? 1792 : 2560, 1024};
            pg8::StaticOrder S; S.init(g.M, g.N, g.K, (int)gridDim.x, (int)blockIdx.x, false);
            const EpiMixIn E{layer, ws, pp->in[11], pp->in[12]};
            pg8::gemm_phase((LAS unsigned char*)shm, g, S, E);
            if (gridDim.x == 256) {
                if (layer == 0 && blockIdx.x >= 206) transpose_tiles(pp, lds, 12, (int)blockIdx.x - 206, 50, 960);
                if (layer == 1 && blockIdx.x >= 148) transpose_tiles(pp, lds, 15, (int)blockIdx.x - 148, 108, 960);
            }
        } else if (op == 6) {
            if (layer == 0) mix_ab_phase(pp, lds); else mix_cd_phase(pp, lds);
        } else {
            final_phase(xs, pp->in[20], pp->out);
        }
    }
}

extern "C" void kernel_launch(void* const* d_in, const int* in_sizes, int n_in, void* d_out, int out_size, void* d_ws, size_t ws_size, hipStream_t stream) {
    static int grid_blocks = 0;
    if (!grid_blocks) {
        int dev = 0, cus = 0, per_cu = 0;
        hipGetDevice(&dev);
        hipDeviceGetAttribute(&cus, hipDeviceAttributeMultiprocessorCount, dev);
        hipFuncSetAttribute((const void*)fwd_megakernel, hipFuncAttributeMaxDynamicSharedMemorySize, LDS_BYTES);
        hipOccupancyMaxActiveBlocksPerMultiprocessor(&per_cu, fwd_megakernel, 512, LDS_BYTES);
        if (per_cu < 1) per_cu = 1;
        grid_blocks = cus * per_cu;
        if (grid_blocks > 256) grid_blocks = 256;
    }
    Params p{};
    for (int i = 0; i < 21; ++i) p.in[i] = (const float*)d_in[i];
    p.out = (float*)d_out; p.ws = (char*)d_ws;
    if (ws_size < WS_NEED) { fprintf(stderr, "workspace too small: %zu < %zu\n", ws_size, (size_t)WS_NEED); }
    hipMemsetAsync((char*)d_ws + OFF_BAR, 0, 16384, stream);
#if MK_MULTI
    for (int s = 0; s < NSTEPS; ++s) { int s0 = s, s1 = s + 1; hipLaunchKernelGGL(fwd_megakernel, dim3(grid_blocks), dim3(512), LDS_BYTES, stream, p, s0, s1); }
#else
    int s0 = 0, s1 = NSTEPS;
    void* args[] = {&p, &s0, &s1};
    hipError_t e = hipLaunchCooperativeKernel((const void*)fwd_megakernel, dim3(grid_blocks), dim3(512), args, LDS_BYTES, stream);
    if (e != hipSuccess) fprintf(stderr, "cooperative launch failed: %s (grid %d)\n", hipGetErrorString(e), grid_blocks);
#endif
}
```

```cpp
#include <hip/hip_runtime.h>
#include <hip/hip_cooperative_groups.h>
#include <cstdio>
namespace cg = cooperative_groups;

#ifndef MK_MULTI
#define MK_MULTI 0
#endif

#define LAS __attribute__((address_space(3)))
typedef unsigned short bf16_t;
typedef short bf16x8 __attribute__((ext_vector_type(8)));
typedef float f32x4 __attribute__((ext_vector_type(4)));
typedef float f32x2 __attribute__((ext_vector_type(2)));
typedef float f32x16 __attribute__((ext_vector_type(16)));
typedef unsigned u32x4 __attribute__((ext_vector_type(4)));
typedef unsigned u32x2 __attribute__((ext_vector_type(2)));

constexpr int TL = 16384, TCX = 512, TT = 16896, DM = 1024, DFF = 2816;
constexpr int SEQ = 8192, CTXL = 256, NKEY = 8448;
constexpr float LOG2E = 1.4426950408889634f;
constexpr float QSCALE = 0.125f * LOG2E;
constexpr int LDS_BYTES = 131072 + 16;

constexpr size_t SZ_W1T = (size_t)5632 * 1024 * 2, SZ_W2T = (size_t)1024 * 2816 * 2;
constexpr size_t OFF_W1T = 0;
constexpr size_t OFF_W2T = OFF_W1T + 4 * SZ_W1T;
constexpr size_t OFF_ABIN = OFF_W2T + 4 * SZ_W2T;
constexpr size_t OFF_ABOUT = OFF_ABIN + (size_t)1792 * 1024 * 2;
constexpr size_t OFF_CDIN = OFF_ABOUT + (size_t)1024 * 1024 * 2;
constexpr size_t OFF_CDOUT = OFF_CDIN + (size_t)2560 * 1024 * 2;
constexpr size_t OFF_MOD = OFF_CDOUT + (size_t)1024 * 1024 * 2;
constexpr size_t OFF_XS = OFF_MOD + (size_t)2 * 3 * 9216 * 4;
constexpr size_t OFF_H = OFF_XS + (size_t)TT * 1024 * 4;
constexpr size_t OFF_A = OFF_H + (size_t)TT * 1024 * 2;
constexpr size_t OFF_BAR = OFF_A + (size_t)TT * 2816 * 2;
constexpr size_t OFF_P = OFF_BAR + 16384;
constexpr size_t OFF_CS = OFF_P + (size_t)11 * 512 * 1024 * 4;
constexpr size_t WS_NEED = OFF_CS + 16384;
constexpr size_t A_Q = OFF_A;
constexpr size_t A_QC = A_Q + (size_t)2 * 12 * SEQ * 64 * 2;
constexpr size_t A_Z = OFF_A + (size_t)TT * 1280 * 2;
constexpr size_t A_KALL = A_Z + (size_t)TT * 512 * 4;
constexpr size_t A_VTALL = A_KALL + (size_t)2 * 4 * NKEY * 64 * 2;
constexpr size_t A_QN = OFF_A;
constexpr size_t A_VTNA = A_QN + (size_t)2 * 8 * SEQ * 64 * 2;
constexpr size_t A_U = OFF_A + (size_t)TT * 1536 * 2;
constexpr size_t A_KNA = A_U + (size_t)TL * 512 * 2;
static_assert(A_QC + (size_t)2 * 12 * 256 * 64 * 2 <= A_Z, "alias overflow");
static_assert(A_VTALL + (size_t)2 * 4 * NKEY * 64 * 2 <= OFF_BAR, "alias overflow");
static_assert(A_VTNA + (size_t)2 * 8 * 64 * NKEY * 2 <= A_U, "alias overflow");
static_assert(A_KNA + (size_t)2 * 8 * NKEY * 64 * 2 <= OFF_BAR, "alias overflow");

struct Params {
    const float* in[21];
    float* out;
    char* ws;
};
typedef const __attribute__((address_space(4))) Params* PP;

__device__ __forceinline__ unsigned cvt_pk_bf16(float lo, float hi) { unsigned r; asm("v_cvt_pk_bf16_f32 %0, %1, %2" : "=v"(r) : "v"(lo), "v"(hi)); return r; }
__device__ __forceinline__ float max3f(float a, float b, float c) { float r; asm("v_max3_f32 %0, %1, %2, %3" : "=v"(r) : "v"(a), "v"(b), "v"(c)); return r; }
__device__ __forceinline__ bf16_t f2bf(float f) { return (bf16_t)(cvt_pk_bf16(f, 0.f) & 0xffffu); }
__device__ __forceinline__ float bf2f(bf16_t b) { return __uint_as_float(((unsigned)b) << 16); }
__device__ __forceinline__ float bflo(unsigned w) { return __uint_as_float(w << 16); }
__device__ __forceinline__ float bfhi(unsigned w) { return __uint_as_float(w & 0xffff0000u); }
__device__ __forceinline__ float fexp2(float x) { return __builtin_amdgcn_exp2f(x); }
__device__ __forceinline__ float frcp(float x) { return __builtin_amdgcn_rcpf(x); }
__device__ __forceinline__ float sigmoidf_(float x) { return frcp(1.0f + fexp2(-x * LOG2E)); }
__device__ __forceinline__ float siluf_(float x) { return x * sigmoidf_(x); }
__device__ __forceinline__ int otid() { int t = threadIdx.x; asm volatile("" : "+v"(t)); return t; }
template <int OFF> __device__ __forceinline__ float shx(float v) { return __int_as_float(__builtin_amdgcn_ds_swizzle(__float_as_int(v), (OFF << 10) | 0x1f)); }
__device__ __forceinline__ float shx32(float v, int lane) { return __int_as_float(__builtin_amdgcn_ds_bpermute((lane ^ 32) << 2, __float_as_int(v))); }
__device__ __forceinline__ float wave_sum(float v, int lane) {
    v += shx32(v, lane); v += shx<16>(v); v += shx<8>(v); v += shx<4>(v); v += shx<2>(v); v += shx<1>(v);
    return v;
}


#define XB_TMO      128
#define XB_XCNT(j)  (256  + 64 * (j))
#define XB_XSUB(j)  (1280 + 64 * (j))
#define XB_XGEN(j)  (2304 + 64 * (j))
#define XB_TOP      3328
#define XB_TOPGEN   3392
#define XCD_BAR_WORDS 3456
#define XB_SPIN_CAP (1u << 20)
__device__ __forceinline__ unsigned xb_ld(unsigned* p)              { return __hip_atomic_load(p, __ATOMIC_RELAXED, __HIP_MEMORY_SCOPE_AGENT); }
__device__ __forceinline__ unsigned xb_add(unsigned* p, unsigned v) { return __hip_atomic_fetch_add(p, v, __ATOMIC_RELAXED, __HIP_MEMORY_SCOPE_AGENT); }
__device__ __forceinline__ unsigned xb_xcc_id() { return (unsigned)__builtin_amdgcn_s_getreg((3 << 11) | 20) & 0xFu; }
#define XB_SPIN(cond, bar) do { unsigned _sp = 0; while (cond) { __builtin_amdgcn_s_sleep(1); \
    if ((++_sp & 255u) == 0u) { if (xb_ld(&(bar)[XB_TMO])) break; if (_sp > XB_SPIN_CAP) { atomicAdd(&(bar)[XB_TMO], 1u); break; } } } } while (0)
struct XcdBarrier { unsigned* bar; unsigned x; volatile LAS unsigned* st; };
__device__ __forceinline__ XcdBarrier xcd_barrier_post(unsigned* bar, volatile LAS unsigned* st) {
    XcdBarrier b; b.bar = bar; b.x = xb_xcc_id(); b.st = st;
    if (threadIdx.x == 0) (void)xb_add(&bar[XB_XCNT(b.x)], 1u);
    return b;
}
__device__ __forceinline__ void xcd_barrier_complete(unsigned* bar, unsigned x, unsigned& nloc, unsigned& nx) {
    const unsigned G = gridDim.x * gridDim.y * gridDim.z;
    unsigned sum, cnt, mine, sp = 0u;
    for (;;) {
        sum = 0u; cnt = 0u; mine = 0u;
#pragma unroll
        for (unsigned j = 0; j < 16; ++j) { const unsigned c = xb_ld(&bar[XB_XCNT(j)]); sum += c; cnt += (c > 0u) ? 1u : 0u; mine = (j == x) ? c : mine; }
        if (sum == G) break;
        __builtin_amdgcn_s_sleep(1);
        if ((++sp & 255u) == 0u) { if (xb_ld(&bar[XB_TMO])) break; if (sp > XB_SPIN_CAP) { atomicAdd(&bar[XB_TMO], 1u); break; } }
    }
    nloc = mine > 0u ? mine : 1u; nx = cnt > 0u ? cnt : 1u;
}
__device__ __forceinline__ void xcd_barrier(const XcdBarrier& b) {
    asm volatile("s_waitcnt vmcnt(0)" ::: "memory");
    __syncthreads();
    if (threadIdx.x == 0) {
        unsigned* bar = b.bar;
        __builtin_amdgcn_s_waitcnt(0);
        unsigned nloc = b.st[0], nx = b.st[1];
        if (nloc == 0u) { xcd_barrier_complete(bar, b.x, nloc, nx); b.st[0] = nloc; b.st[1] = nx; }
        const unsigned old = xb_add(&bar[XB_XSUB(b.x)], 1u);
        const unsigned gen = old / nloc;
        if (old + 1u == (gen + 1u) * nloc) {
            __builtin_amdgcn_fence(__ATOMIC_RELEASE, "agent");
            asm volatile("s_waitcnt vmcnt(0)" ::: "memory");
            const unsigned og = xb_add(&bar[XB_TOP], 1u);
            const unsigned tg = og / nx;
            if (og + 1u == (tg + 1u) * nx) xb_add(&bar[XB_TOPGEN], 1u);
            else XB_SPIN(xb_ld(&bar[XB_TOPGEN]) == tg, bar);
            __builtin_amdgcn_fence(__ATOMIC_ACQUIRE, "agent");
            xb_add(&bar[XB_XGEN(b.x)], 1u);
            asm volatile("s_waitcnt vmcnt(0)" ::: "memory");
        } else {
            XB_SPIN(xb_ld(&bar[XB_XGEN(b.x)]) == gen, bar);
            __builtin_amdgcn_fence(__ATOMIC_ACQUIRE, "agent");
            asm volatile("s_waitcnt vmcnt(0)" ::: "memory");
        }
    }
    __syncthreads();
}

namespace pg8 {
constexpr int BM = 256, BK = 64, HALF = 128, HTB = HALF * BK * 2, STAGE_BYTES = 8 * HTB, NXCD = 8, WGM = 4;
__device__ __forceinline__ int lds_byte(int r, int c) { const int st = (r >> 4) * 2 + (c >> 5), rr = r & 15, cc = c & 31, ob = rr * 64 + cc * 2; return st * 1024 + (ob ^ (((ob >> 9) & 1) << 5)); }
__device__ __forceinline__ void stage_rc(int b, int& R, int& C) { const int st = b / 1024, sb = b % 1024, swz = sb ^ (((sb >> 9) & 1) << 5); R = (st >> 1) * 16 + swz / 64; C = (st & 1) * 32 + (swz % 64) / 2; }
__device__ __forceinline__ int perm32(int rho) { const int n = rho >> 4, i = rho & 15; return 8 * (i >> 2) + 4 * n + (i & 3); }
struct Unit { int pm, pn, chunk; };
struct Gemm { const bf16_t* A; const bf16_t* Bt; int M, N, K; };
struct StaticOrder {
    int nM, nN, nwg, G, c, nt, nsplit;
    __device__ void init(int M, int N, int K, int G_, int c_, bool split_ctx) {
        nM = M / BM; nN = N / BM; nt = K / BK; G = G_; c = c_; nsplit = 0;
        if (split_ctx) { nM = 64; nsplit = 8 * (nt / 4); }
        nwg = nM * nN;
    }
    __device__ bool next(int i, Unit& u) const {
        const long L = (long)i * G + c;
        const int idx = (int)(L - nwg);
        const bool split = L >= nwg;
        int wgid = split ? 0 : (int)L; { const int q = nwg / NXCD, r = nwg % NXCD, xcd = wgid % NXCD, off = wgid / NXCD; wgid = (xcd < r ? xcd * (q + 1) : r * (q + 1) + (xcd - r) * q) + off; }
        const int nig = WGM * nN, gid = wgid / nig, fm = gid * WGM, gsz = (nM - fm) < WGM ? (nM - fm) : WGM;
        const int pm = fm + ((wgid % nig) % gsz), pn = (wgid % nig) / gsz;
        u.pm = split ? 64 + ((idx >> 2) & 1) : pm; u.pn = split ? (idx & 3) : pn; u.chunk = split ? (idx >> 3) : -1;
        return split ? idx < nsplit : true;
    }
};
template <class Epi>
__device__ __forceinline__ void gemm_phase(LAS unsigned char* lds, const Gemm g, const StaticOrder& S, const Epi& E) {
    const int tid = otid(), wid = __builtin_amdgcn_readfirstlane(tid >> 6), lane = tid & 63, wr = wid >> 2, wc = wid & 3, fr = lane & 15, fq = lane >> 4;
    const int K = g.K;
    unsigned voffA[2], voffB[2];
#pragma unroll
    for (int i = 0; i < 2; ++i) { int R, C; stage_rc(tid * 16 + i * 8192, R, C); const int Rb = (R & ~31) + perm32(R & 31);
        voffA[i] = (unsigned)(R * K + C) * 2u; voffB[i] = (unsigned)(Rb * K + C) * 2u; }
    const size_t kstep = (size_t)(BK * 2);
    const size_t hstep = (size_t)HALF * K * 2;
    const size_t tstep = 2 * hstep;
    const unsigned ldsw = (unsigned)wid * 1024u;
    const int aoff = lds_byte(wr * 64 + fr, fq * 8), boff = lds_byte(wc * 32 + fr, fq * 8);
#define PG8_SA(b, h) (((b) * 2 + (h)) * HTB)
#define PG8_SB(b, h) ((4 + (b) * 2 + (h)) * HTB)
#define PG8_STAGE(bufoff, gbase, voff) do { _Pragma("unroll") for (int _i = 0; _i < 2; ++_i) \
        __builtin_amdgcn_global_load_lds((const unsigned*)((const char*)(gbase) + (voff)[_i]), (LAS unsigned*)(lds + (bufoff) + ldsw + _i * 8192), 16, 0, 0); } while (0)
#define PG8_LDA(dst, b, h) do { _Pragma("unroll") for (int m = 0; m < 4; ++m) _Pragma("unroll") for (int k = 0; k < 2; ++k) dst[m][k] = *(const LAS bf16x8*)(lds + PG8_SA(b, h) + aoff + m * 2048 + k * 1024); } while (0)
#define PG8_LDB(dst, b, h) do { _Pragma("unroll") for (int n = 0; n < 2; ++n) _Pragma("unroll") for (int k = 0; k < 2; ++k) dst[n][k] = *(const LAS bf16x8*)(lds + PG8_SB(b, h) + boff + n * 2048 + k * 1024); } while (0)
#define PG8_MMA(ai, bj, At, Bt) do { __builtin_amdgcn_s_setprio(1); _Pragma("unroll") for (int m = 0; m < 4; ++m) _Pragma("unroll") for (int n = 0; n < 2; ++n) _Pragma("unroll") for (int k = 0; k < 2; ++k) \
        acc[ai][bj][m][n] = __builtin_amdgcn_mfma_f32_16x16x32_bf16(Bt[n][k], At[m][k], acc[ai][bj][m][n], 0, 0, 0); __builtin_amdgcn_s_setprio(0); } while (0)
#define PG8_WAIT_V(n) asm volatile("s_waitcnt vmcnt(" #n ")" ::: "memory")
#define PG8_WAIT_L(n) asm volatile("s_waitcnt lgkmcnt(" #n ")" ::: "memory")
#define PG8_BAR __builtin_amdgcn_s_barrier()
#define PG8_SCHED __builtin_amdgcn_sched_barrier(0)
    Unit cur, nxt; int ui = 0;
    if (!S.next(0, cur)) return;
    f32x4 acc[2][2][4][2];
#pragma unroll
    for (int a = 0; a < 2; ++a)
#pragma unroll
        for (int b = 0; b < 2; ++b)
#pragma unroll
            for (int m = 0; m < 4; ++m)
#pragma unroll
                for (int n = 0; n < 2; ++n) acc[a][b][m][n] = (f32x4){0.f, 0.f, 0.f, 0.f};
    bf16x8 At[4][2], B0[2][2], B1[2][2];
    const char* cA = (const char*)g.A + (size_t)cur.pm * tstep + (size_t)(cur.chunk < 0 ? 0 : cur.chunk * 4) * kstep; const char* cB = (const char*)g.Bt + (size_t)cur.pn * tstep + (size_t)(cur.chunk < 0 ? 0 : cur.chunk * 4) * kstep;
    PG8_STAGE(PG8_SB(0, 0), cB, voffB); PG8_STAGE(PG8_SA(0, 0), cA, voffA); PG8_STAGE(PG8_SB(0, 1), cB + hstep, voffB); PG8_STAGE(PG8_SA(0, 1), cA + hstep, voffA);
    if (wr == 1) PG8_BAR;
    PG8_WAIT_V(4); PG8_BAR;
    PG8_STAGE(PG8_SB(1, 0), cB + kstep, voffB); PG8_STAGE(PG8_SA(1, 0), cA + kstep, voffA); PG8_STAGE(PG8_SB(1, 1), cB + hstep + kstep, voffB);
    PG8_WAIT_V(6); PG8_BAR;
    for (;;) {
        const bool has_next = S.next(ui + 1, nxt);
        const char* nA = has_next ? (const char*)g.A + (size_t)nxt.pm * tstep + (size_t)(nxt.chunk < 0 ? 0 : nxt.chunk * 4) * kstep : cA; const char* nB = has_next ? (const char*)g.Bt + (size_t)nxt.pn * tstep + (size_t)(nxt.chunk < 0 ? 0 : nxt.chunk * 4) * kstep : cB;
        const int nt = cur.chunk < 0 ? S.nt : 4;
        for (int t = 0; t < nt; t += 2) {
            const bool last = (t == nt - 2);
            const char* a1 = cA + (size_t)(t + 1) * kstep;
            const char* a2 = last ? nA : cA + (size_t)(t + 2) * kstep; const char* b2 = last ? nB : cB + (size_t)(t + 2) * kstep;
            const char* a3 = a2 + kstep; const char* b3 = b2 + kstep;
            PG8_LDB(B0, 0, 0); PG8_SCHED; PG8_LDA(At, 0, 0); PG8_STAGE(PG8_SA(1, 1), a1 + hstep, voffA);
            PG8_WAIT_L(8); PG8_BAR; PG8_WAIT_L(0); PG8_MMA(0, 0, At, B0); PG8_BAR; PG8_SCHED;
            PG8_LDB(B1, 0, 1); PG8_STAGE(PG8_SB(0, 0), b2, voffB);
            PG8_BAR; PG8_WAIT_L(0); PG8_MMA(0, 1, At, B1); PG8_BAR;
            PG8_LDA(At, 0, 1); PG8_STAGE(PG8_SA(0, 0), a2, voffA);
            PG8_BAR; PG8_WAIT_L(0); PG8_MMA(1, 0, At, B0); PG8_BAR; PG8_SCHED;
            PG8_STAGE(PG8_SB(0, 1), b2 + hstep, voffB);
            PG8_WAIT_V(6); PG8_BAR; PG8_MMA(1, 1, At, B1); PG8_BAR;
            PG8_LDB(B0, 1, 0); PG8_SCHED; PG8_LDA(At, 1, 0); PG8_STAGE(PG8_SA(0, 1), a2 + hstep, voffA);
            PG8_WAIT_L(8); PG8_BAR; PG8_WAIT_L(0); PG8_MMA(0, 0, At, B0); PG8_BAR; PG8_SCHED;
            PG8_LDB(B1, 1, 1); PG8_STAGE(PG8_SB(1, 0), b3, voffB);
            PG8_BAR; PG8_WAIT_L(0); PG8_MMA(0, 1, At, B1); PG8_BAR;
            PG8_LDA(At, 1, 1); PG8_STAGE(PG8_SA(1, 0), a3, voffA);
            PG8_BAR; PG8_WAIT_L(0); PG8_MMA(1, 0, At, B0); PG8_BAR; PG8_SCHED;
            PG8_STAGE(PG8_SB(1, 1), b3 + hstep, voffB);
            PG8_WAIT_V(6); PG8_BAR; PG8_MMA(1, 1, At, B1); PG8_BAR;
        }
        E(acc, cur, wr, wc, fr, fq);
        if (!has_next) break;
#pragma unroll
        for (int a = 0; a < 2; ++a)
#pragma unroll
            for (int b = 0; b < 2; ++b)
#pragma unroll
                for (int m = 0; m < 4; ++m)
#pragma unroll
                    for (int n = 0; n < 2; ++n) acc[a][b][m][n] = (f32x4){0.f, 0.f, 0.f, 0.f};
        cur = nxt; cA = nA; cB = nB; ++ui;
    }
    PG8_WAIT_V(0);
    if (wr == 0) PG8_BAR;
    PG8_BAR;
#undef PG8_SA
#undef PG8_SB
#undef PG8_STAGE
#undef PG8_LDA
#undef PG8_LDB
#undef PG8_MMA
#undef PG8_WAIT_V
#undef PG8_WAIT_L
#undef PG8_BAR
#undef PG8_SCHED
}
}
using pg8::Unit;
typedef f32x4 AccT[2][2][4][2];

struct EpiSwiglu {
    bf16_t* O;
    __device__ __forceinline__ void operator()(const AccT& acc, const Unit& u, int wr, int wc, int fr, int fq) const {
        const int row0 = u.pm * 256 + wr * 64 + fr, col0 = u.pn * 128 + wc * 32 + 8 * fq;
#pragma unroll
        for (int ai = 0; ai < 2; ++ai)
#pragma unroll
            for (int m = 0; m < 4; ++m) {
                bf16_t* rowp = O + (size_t)(row0 + ai * 128 + m * 16) * DFF + col0;
                float v[8];
#pragma unroll
                for (int n = 0; n < 2; ++n)
#pragma unroll
                    for (int j = 0; j < 4; ++j) { const float g2 = acc[ai][0][m][n][j]; v[n * 4 + j] = (g2 * frcp(1.0f + fexp2(-g2))) * acc[ai][1][m][n][j]; }
                u32x4 w; w.x = cvt_pk_bf16(v[0], v[1]); w.y = cvt_pk_bf16(v[2], v[3]); w.z = cvt_pk_bf16(v[4], v[5]); w.w = cvt_pk_bf16(v[6], v[7]);
                *(u32x4*)rowp = w;
            }
    }
};
struct EpiResid {
    const float* xin_lat; const float* xin_ctx;
    char* ws; int gate_off; int mixout;
    __device__ __forceinline__ void operator()(const AccT& acc, const Unit& u, int wr, int wc, int fr, int fq) const {
        const int row0 = u.pm * 256 + wr * 64 + fr, col0 = u.pn * 256 + wc * 32 + 8 * fq;
        const int v = u.pm < 32 ? 0 : (u.pm < 64 ? 1 : 2);
        const float coef = mixout ? 1.0f : 0.5f;
        float* const xout = (float*)(ws + OFF_XS); float* const P = (float*)(ws + OFF_P);
        const float* gp = (const float*)(ws + OFF_MOD) + gate_off + v * 9216 + col0;
        f32x4 gv[2][2];
#pragma unroll
        for (int bj = 0; bj < 2; ++bj)
#pragma unroll
            for (int n = 0; n < 2; ++n) gv[bj][n] = *(const f32x4*)(gp + bj * 128 + 4 * n) * coef;
        if (u.chunk >= 0) {
            float* pb = P + (size_t)u.chunk * 512 * DM;
#pragma unroll
            for (int ai = 0; ai < 2; ++ai)
#pragma unroll
                for (int m = 0; m < 4; ++m) {
                    const size_t base = (size_t)(row0 - TL + ai * 128 + m * 16) * DM + col0;
#pragma unroll
                    for (int bj = 0; bj < 2; ++bj)
#pragma unroll
                        for (int n = 0; n < 2; ++n) *(f32x4*)(pb + base + bj * 128 + 4 * n) = gv[bj][n] * acc[ai][bj][m][n];
                }
            return;
        }
        const float* src = u.pm < 64 ? xin_lat : xin_ctx;
#pragma unroll
        for (int ai = 0; ai < 2; ++ai)
#pragma unroll
            for (int m = 0; m < 4; ++m) {
                const size_t base = (size_t)(row0 + ai * 128 + m * 16) * DM + col0;
#pragma unroll
                for (int bj = 0; bj < 2; ++bj)
#pragma unroll
                    for (int n = 0; n < 2; ++n) {
                        const f32x4 xv = *(const f32x4*)(src + base + bj * 128 + 4 * n);
                        *(f32x4*)(xout + base + bj * 128 + 4 * n) = xv + gv[bj][n] * acc[ai][bj][m][n];
                    }
            }
    }
};
__device__ __forceinline__ void store_bf16_tile(const AccT& acc, bf16_t* O, int ldo, int row0, int col0) {
#pragma unroll
    for (int ai = 0; ai < 2; ++ai)
#pragma unroll
        for (int m = 0; m < 4; ++m) {
            bf16_t* rowp = O + (size_t)(row0 + ai * 128 + m * 16) * ldo + col0;
#pragma unroll
            for (int bj = 0; bj < 2; ++bj) {
                const f32x4 v0 = acc[ai][bj][m][0], v1 = acc[ai][bj][m][1];
                u32x4 w; w.x = cvt_pk_bf16(v0[0], v0[1]); w.y = cvt_pk_bf16(v0[2], v0[3]); w.z = cvt_pk_bf16(v1[0], v1[1]); w.w = cvt_pk_bf16(v1[2], v1[3]);
                *(u32x4*)(rowp + bj * 128) = w;
            }
        }
}
struct EpiMixIn {
    int layer; char* ws; const float* qn; const float* kn;
    __device__ __forceinline__ void operator()(const AccT& acc, const Unit& u, int wr, int wc, int fr, int fq) const {
        const int row0 = u.pm * 256 + wr * 64 + fr, cw = wc * 32 + 8 * fq;
        const int lane = fq * 16 + fr;
        const bool l0 = layer == 0;
        const int qt0 = l0 ? 0 : 4, nqt = l0 ? 3 : 2, nkt = l0 ? 1 : 2;
        const int rel = u.pn - qt0;
        if (rel >= 0 && rel < nqt + 2 * nkt) {
            const bool isctx = u.pm >= 64;
            const int kind = rel < nqt ? 0 : (rel < nqt + nkt ? 1 : 2);
            const int head = (kind == 0 ? rel : (kind == 1 ? rel - nqt : rel - nqt - nkt)) * 4 + wc;
            const int nqh = l0 ? 12 : 8, nkv = l0 ? 4 : 8;
            if (kind == 2) {
                bf16_t* VT = (bf16_t*)(ws + (l0 ? A_VTALL : A_VTNA));
#pragma unroll
                for (int ai = 0; ai < 2; ++ai)
#pragma unroll
                    for (int m = 0; m < 4; ++m) {
                        const int r = row0 + ai * 128 + m * 16;
                        const int b = isctx ? (r - TL) >> 8 : r >> 13, n = isctx ? (r - TL) & 255 : r & 8191;
                        const int pos = isctx ? n : CTXL + n, ppos = (pos & ~12) | ((pos & 4) << 1) | ((pos & 8) >> 1);
                        bf16_t* dst = VT + (size_t)(b * nkv + head) * 64 * NKEY + ppos;
#pragma unroll
                        for (int bj = 0; bj < 2; ++bj)
#pragma unroll
                            for (int n2 = 0; n2 < 2; ++n2)
#pragma unroll
                                for (int j = 0; j < 4; ++j) dst[(size_t)(32 * bj + 8 * fq + 4 * n2 + j) * NKEY] = f2bf(acc[ai][bj][m][n2][j]);
                    }
            } else if (!(isctx && kind == 0 && !l0)) {
                f32x4 nw[2][2];
                if (l0) { const float* np = (kind == 0 ? qn : kn) + 8 * fq;
#pragma unroll
                    for (int bj = 0; bj < 2; ++bj)
#pragma unroll
                        for (int n2 = 0; n2 < 2; ++n2) nw[bj][n2] = *(const f32x4*)(np + 32 * bj + 4 * n2); }
                const float osc = kind == 0 ? QSCALE : 1.0f;
                float nmax = 0.f;
                const f32x4* cs = (const f32x4*)(ws + OFF_CS);
#pragma unroll
                for (int ai = 0; ai < 2; ++ai)
#pragma unroll
                    for (int m = 0; m < 4; ++m) {
                        const int r = row0 + ai * 128 + m * 16;
                        const int b = isctx ? (r - TL) >> 8 : r >> 13, n = isctx ? (r - TL) & 255 : r & 8191;
                        f32x4 x[2][2];
#pragma unroll
                        for (int bj = 0; bj < 2; ++bj)
#pragma unroll
                            for (int n2 = 0; n2 < 2; ++n2) x[bj][n2] = acc[ai][bj][m][n2];
                        if (!l0) {
                            float ss = 0.f;
#pragma unroll
                            for (int bj = 0; bj < 2; ++bj)
#pragma unroll
                                for (int n2 = 0; n2 < 2; ++n2) ss += x[bj][n2][0] * x[bj][n2][0] + x[bj][n2][1] * x[bj][n2][1] + x[bj][n2][2] * x[bj][n2][2] + x[bj][n2][3] * x[bj][n2][3];
                            ss += shx<16>(ss); ss += shx32(ss, lane);
                            nmax = fmaxf(nmax, ss);
                        }
                        if (l0) {
                            float ss = 0.f;
#pragma unroll
                            for (int bj = 0; bj < 2; ++bj)
#pragma unroll
                                for (int n2 = 0; n2 < 2; ++n2) ss += x[bj][n2][0] * x[bj][n2][0] + x[bj][n2][1] * x[bj][n2][1] + x[bj][n2][2] * x[bj][n2][2] + x[bj][n2][3] * x[bj][n2][3];
                            ss += shx<16>(ss); ss += shx32(ss, lane);
                            const float rs = rsqrtf(ss * (1.0f / 64.0f) + 1e-6f);
#pragma unroll
                            for (int bj = 0; bj < 2; ++bj)
#pragma unroll
                                for (int n2 = 0; n2 < 2; ++n2) x[bj][n2] = x[bj][n2] * rs * nw[bj][n2];
                            if (!isctx) {
                                const int pos = fq < 2 ? (n >> 6) : (n & 63);
                                const f32x4* cp = cs + (pos * 16 + ((8 * fq) & 15)) / 2;
#pragma unroll
                                for (int n2 = 0; n2 < 2; ++n2) {
                                    const f32x4 c01 = cp[n2 * 2], c23 = cp[n2 * 2 + 1];
                                    const float co[4] = {c01[0], c01[2], c23[0], c23[2]}, si[4] = {c01[1], c01[3], c23[1], c23[3]};
#pragma unroll
                                    for (int j = 0; j < 4; ++j) { const float x1 = x[0][n2][j], x2 = x[1][n2][j];
                                        x[0][n2][j] = x1 * co[j] - x2 * si[j]; x[1][n2][j] = x2 * co[j] + x1 * si[j]; }
                                }
                            }
                        }
                        bf16_t* dst;
                        if (kind == 0) dst = isctx ? (bf16_t*)(ws + A_QC) + ((size_t)(b * 12 + head) * CTXL + n) * 64
                                                   : (bf16_t*)(ws + (l0 ? A_Q : A_QN)) + ((size_t)(b * nqh + head) * SEQ + n) * 64;
                        else dst = (bf16_t*)(ws + (l0 ? A_KALL : A_KNA)) + ((size_t)(b * nkv + head) * NKEY + (isctx ? n : CTXL + n)) * 64;
#pragma unroll
                        for (int bj = 0; bj < 2; ++bj) {
                            u32x4 w; w.x = cvt_pk_bf16(x[bj][0][0] * osc, x[bj][0][1] * osc); w.y = cvt_pk_bf16(x[bj][0][2] * osc, x[bj][0][3] * osc);
                            w.z = cvt_pk_bf16(x[bj][1][0] * osc, x[bj][1][1] * osc); w.w = cvt_pk_bf16(x[bj][1][2] * osc, x[bj][1][3] * osc);
                            *(u32x4*)(dst + 32 * bj + 8 * fq) = w;
                        }
                    }
                if (!l0) {
                    nmax = fmaxf(nmax, shx<8>(nmax)); nmax = fmaxf(nmax, shx<4>(nmax)); nmax = fmaxf(nmax, shx<2>(nmax)); nmax = fmaxf(nmax, shx<1>(nmax));
                    if (lane == 0) (void)__hip_atomic_fetch_max((unsigned*)(ws + OFF_BAR) + (kind == 0 ? 3600 : 3664), __float_as_uint(nmax), __ATOMIC_RELAXED, __HIP_MEMORY_SCOPE_AGENT);
                }
            }
        } else if (l0) {
            float* Z = (float*)(ws + A_Z);
            const int col0 = (u.pn - 5) * 256 + cw;
#pragma unroll
            for (int ai = 0; ai < 2; ++ai)
#pragma unroll
                for (int m = 0; m < 4; ++m) {
                    float* rowp = Z + (size_t)(row0 + ai * 128 + m * 16) * 512 + col0;
#pragma unroll
                    for (int bj = 0; bj < 2; ++bj)
#pragma unroll
                        for (int n = 0; n < 2; ++n) *(f32x4*)(rowp + bj * 128 + 4 * n) = acc[ai][bj][m][n];
                }
        } else if (u.pm < 64) {
            bf16_t* U = (bf16_t*)(ws + A_U);
            const int col0 = u.pn * 128 + cw;
#pragma unroll
            for (int ai = 0; ai < 2; ++ai)
#pragma unroll
                for (int m = 0; m < 4; ++m) {
                    bf16_t* rowp = U + (size_t)(row0 + ai * 128 + m * 16) * 512 + col0;
                    float v[8];
#pragma unroll
                    for (int n = 0; n < 2; ++n)
#pragma unroll
                        for (int j = 0; j < 4; ++j) v[n * 4 + j] = acc[ai][0][m][n][j] * frcp(1.0f + fexp2(-acc[ai][1][m][n][j]));
                    u32x4 w; w.x = cvt_pk_bf16(v[0], v[1]); w.y = cvt_pk_bf16(v[2], v[3]); w.z = cvt_pk_bf16(v[4], v[5]); w.w = cvt_pk_bf16(v[6], v[7]);
                    *(u32x4*)rowp = w;
                }
        }
    }
};

__device__ __forceinline__ void conv_tile(float* tl, const float* src, int ld, int col0, int k0, bf16_t* dst, int K) {
    const int tid = otid();
    { const int r = tid >> 4, c4 = (tid & 15) * 4;
#pragma unroll
      for (int i = 0; i < 2; ++i) { const int kk = r + 32 * i; const f32x4 v = *(const f32x4*)(src + (size_t)(k0 + kk) * ld + col0 + c4);
          tl[kk * 65 + c4 + 0] = v[0]; tl[kk * 65 + c4 + 1] = v[1]; tl[kk * 65 + c4 + 2] = v[2]; tl[kk * 65 + c4 + 3] = v[3]; } }
    __syncthreads();
    { const int nn = tid >> 3, kc = (tid & 7) * 8; float v[8];
#pragma unroll
      for (int j = 0; j < 8; ++j) v[j] = tl[(kc + j) * 65 + nn];
      u32x4 w; w.x = cvt_pk_bf16(v[0], v[1]); w.y = cvt_pk_bf16(v[2], v[3]); w.z = cvt_pk_bf16(v[4], v[5]); w.w = cvt_pk_bf16(v[6], v[7]);
      *(u32x4*)(dst + (size_t)nn * K + kc) = w; }
    __syncthreads();
}

__device__ void transpose_tiles(PP pp, char* lds, int part, int first, int stride, int total) {
    const int tid = otid();
    float* fl = (float*)lds;
    const int wid = __builtin_amdgcn_readfirstlane(tid >> 6), lane = tid & 63;
    float* wl = fl + 3200 + wid * (64 * 33);
    for (int it4 = first; it4 * 4 < total; it4 += stride) {
        int u = it4 * 4 + (wid >> 1); const int nh = wid & 1;
        const bool valid = u < total;
        if (!valid) u = 0;
        int t = u;
        if (part == 11) t = u < 704 ? 5632 + u : (u < 1024 ? 8448 + (u - 704) : 1408 + (u - 1024));
        if (part == 12) t = u < 256 ? 8768 + u : 6336 + (u - 256);
        if (part == 13) t = u < 1408 ? 2816 + u : 7040 + (u - 1408);
        if (part == 14) t = u < 640 ? 9024 + u : 4224 + (u - 640);
        if (part == 15) t = u < 256 ? 9664 + u : 7744 + (u - 256);
        const float* src; int ld, col0, K, ntk; bf16_t* dst; int j; bool perm = false; float wsc = 1.0f;
        if (t < 5632) {
            const int w = t / 1408; t %= 1408; K = 1024; ntk = 16; j = t / ntk;
            const int pn = j >> 2, q = j & 3;
            src = (q < 2 ? pp->in[6] : pp->in[7]) + (size_t)w * 1024 * 2816; ld = 2816; col0 = pn * 128 + (q & 1) * 64;
            wsc = q < 2 ? LOG2E : 1.0f / LOG2E;
            dst = (bf16_t*)(pp->ws + OFF_W1T + w * SZ_W1T);
        } else if (t < 5632 + 2816) {
            t -= 5632; const int w = t / 704; t %= 704; K = 2816; ntk = 44; j = t / ntk;
            src = pp->in[8] + (size_t)w * 2816 * 1024; ld = 1024; col0 = j * 64;
            dst = (bf16_t*)(pp->ws + OFF_W2T + w * SZ_W2T);
        } else if (t < 8448 + 320) {
            t -= 8448; K = 1024; ntk = 16; j = t / ntk; src = pp->in[9]; ld = 1536; col0 = j * 64; dst = (bf16_t*)(pp->ws + OFF_ABIN); perm = true;
        } else if (t < 8768 + 256) {
            t -= 8768; K = 1024; ntk = 16; j = t / ntk; src = pp->in[10]; ld = 1024; col0 = j * 64; dst = (bf16_t*)(pp->ws + OFF_ABOUT);
        } else if (t < 9024 + 640) {
            t -= 9024; K = 1024; ntk = 16; j = t / ntk; src = pp->in[13]; ld = 2560;
            if (j < 16) { const int pn = j >> 2, q = j & 3; col0 = (q < 2 ? 0 : 512) + pn * 128 + (q & 1) * 64; if (q >= 2) wsc = LOG2E;   } else { col0 = j * 64; perm = true; }
            dst = (bf16_t*)(pp->ws + OFF_CDIN);
        } else {
            t -= 9664; K = 1024; ntk = 16; j = t / ntk; src = pp->in[14]; ld = 1024; col0 = j * 64; dst = (bf16_t*)(pp->ws + OFF_CDOUT);
        }
        const int k0 = (t % ntk) * 64;
        int scol = col0 + nh * 32;
        if (perm) { const int C = j * 2 + nh, c8 = C & 7; scol = ((C >> 3) * 8 + (c8 & 3) * 2 + (c8 >> 2)) * 32; }
        const float* sp = src + (size_t)(k0 + (lane >> 3)) * ld + scol + (lane & 7) * 4;
        f32x4 v[8];
#pragma unroll
        for (int i = 0; i < 8; ++i) v[i] = __builtin_nontemporal_load((const f32x4*)(sp + (size_t)(8 * i) * ld));
#pragma unroll
        for (int i = 0; i < 8; ++i) { float* q = wl + (8 * i + (lane >> 3)) * 33 + (lane & 7) * 4; q[0] = v[i][0] * wsc; q[1] = v[i][1] * wsc; q[2] = v[i][2] * wsc; q[3] = v[i][3] * wsc; }
        __syncthreads();
        { const int nn = lane >> 1, kh = (lane & 1) * 32;
          bf16_t* dp = dst + (size_t)(j * 64 + nh * 32 + nn) * K + k0 + kh;
#pragma unroll
          for (int c = 0; c < 4; ++c) { float f[8];
#pragma unroll
              for (int e = 0; e < 8; ++e) f[e] = wl[(kh + c * 8 + e) * 33 + nn];
              u32x4 w; w.x = cvt_pk_bf16(f[0], f[1]); w.y = cvt_pk_bf16(f[2], f[3]); w.z = cvt_pk_bf16(f[4], f[5]); w.w = cvt_pk_bf16(f[6], f[7]);
              if (valid) *(u32x4*)(dp + c * 8) = w; } }
        __syncthreads();
    }
}

__device__ void prep_phase(PP pp, char* lds) {
    const int tid = otid();
    float* fl = (float*)lds;
    for (int i = tid; i < 3072; i += 512) { const float c = i < 2048 ? pp->in[1][i] : pp->in[3][i - 2048]; fl[i] = c / (1.0f + expf(-c)); }
    float* ct = fl + 3072;
    float* st = fl + 3136;
    if (tid < 64) { float s, c; sincospif((float)tid / 32.0f, &s, &c); ct[tid] = c; st[tid] = s; }
    if (blockIdx.x == gridDim.x - 1) {
        f32x2* cst = (f32x2*)(pp->ws + OFF_CS);
        for (int i = tid; i < 2048; i += 512) { const int pos = i >> 4, jj = i & 15; const float inv = powf(10000.0f, -(float)jj / 16.0f); const float ang = (float)pos * inv;
            float sn, cn; sincosf(ang, &sn, &cn); cst[i] = (f32x2){cn, sn}; }
    }
    float* red = fl + 3200;
    float* tl = fl + 3200;
    __syncthreads();
    constexpr int N_GEMV = 288, N_Z = 64, N_TR = 9920;
    for (int item = blockIdx.x; item < N_GEMV + N_Z; item += gridDim.x) {
        if (item < N_GEMV) {
            const int layer = item / 144, n0 = (item % 144) * 64, cl = tid & 15, ks = tid >> 4;
            const float* W = pp->in[4] + ((size_t)layer * 1024 + ks * 32) * 9216 + n0 + cl * 4;
            float a[3][4];
#pragma unroll
            for (int v = 0; v < 3; ++v)
#pragma unroll
                for (int j = 0; j < 4; ++j) a[v][j] = 0.f;
#pragma unroll 8
            for (int kk = 0; kk < 32; ++kk) {
                const f32x4 w = __builtin_nontemporal_load((const f32x4*)(W + (size_t)kk * 9216));
#pragma unroll
                for (int v = 0; v < 3; ++v) { const float s = fl[v * 1024 + ks * 32 + kk];
#pragma unroll
                    for (int j = 0; j < 4; ++j) a[v][j] += s * w[j]; }
            }
#pragma unroll
            for (int v = 0; v < 3; ++v)
#pragma unroll
                for (int j = 0; j < 4; ++j) red[(ks * 16 + cl) * 12 + v * 4 + j] = a[v][j];
            __syncthreads();
            if (tid < 192) { const int c2 = tid / 12, vj = tid % 12, v = vj >> 2, j = vj & 3; float s = 0.f;
                for (int k2 = 0; k2 < 32; ++k2) s += red[(k2 * 16 + c2) * 12 + vj];
                const int n = n0 + c2 * 4 + j;
                ((float*)(pp->ws + OFF_MOD))[(layer * 3 + v) * 9216 + n] = s + pp->in[5][layer * 9216 + n]; }
            __syncthreads();
        } else if (item < N_GEMV + N_Z) {
            const int zi = item - N_GEMV, g = zi >> 4, k0 = (zi & 15) * 64;
            const float* src = pp->in[9];
            { const int r = tid >> 4, c4 = (tid & 15) * 4;
#pragma unroll
              for (int i = 0; i < 2; ++i) { const int kk = r + 32 * i; const f32x4 v = *(const f32x4*)(src + (size_t)(k0 + kk) * 1536 + 1280 + g * 64 + c4);
                  tl[kk * 65 + c4 + 0] = v[0]; tl[kk * 65 + c4 + 1] = v[1]; tl[kk * 65 + c4 + 2] = v[2]; tl[kk * 65 + c4 + 3] = v[3]; } }
            __syncthreads();
            const int kk = tid & 63, mp0 = tid >> 6;
            bf16_t* dst = (bf16_t*)(pp->ws + OFF_ABIN) + (size_t)(1280 + g * 128) * 1024 + k0 + kk;
            for (int e = 0; e < 16; ++e) {
                const int nl = mp0 * 16 + e, m = nl >> 1, part = nl & 1;
                float s = 0.f;
                for (int c = 0; c < 64; ++c) { const int idx = (m * c) & 63; const float t = part ? -st[idx] : ct[idx]; s += tl[kk * 65 + c] * t; }
                dst[(size_t)nl * 1024] = f2bf(s);
            }
            __syncthreads();
        }
    }
    if (gridDim.x == 256) transpose_tiles(pp, lds, 10, blockIdx.x, gridDim.x, 1408);
    else transpose_tiles(pp, lds, 0, blockIdx.x, gridDim.x, N_TR);
}

__device__ void norm_phase(const float* xlat, const float* xctx, int nrows, const float* modl, int si, int ci, bf16_t* h, int cmode, int nch, float* xs, const float* P) {
    const int tid = otid(), wid = tid >> 6, lane = tid & 63;
    const int nw = gridDim.x * 8;
    const int w0 = blockIdx.x * 8 + wid;
    const int nlat = nrows < TL ? nrows : TL, nctx = nrows - nlat;
    const int npre = (nctx > 0 && (w0 & 3) == 3) ? (nctx - (w0 >> 2) + (nw >> 2) - 1) / (nw >> 2) : 0;
    const int npair = (nlat - w0 + 2 * nw - 1) / (2 * nw);
    for (int itn = 0; itn < npre + (npair > 0 ? npair : 0); ++itn) {
        const bool pre = itn < npre;
        const int r0 = pre ? TL + (w0 >> 2) + itn * (nw >> 2) : w0 + (itn - npre) * 2 * nw;
        const int r1 = r0 + nw; const bool has1 = !pre && r1 < nlat;
        const int rr[2] = {r0, has1 ? r1 : r0};
        f32x4 x[2][4]; float ss[2] = {0.f, 0.f};
#pragma unroll
        for (int q = 0; q < 2; ++q) {
            const int r = rr[q];
            const float* src = r < TL ? xlat + (size_t)r * DM : xctx + (size_t)(r - TL) * DM;
#pragma unroll
            for (int i = 0; i < 4; ++i) x[q][i] = *(const f32x4*)(src + i * 256 + lane * 4);
        }
#pragma unroll
        for (int q = 0; q < 2; ++q) {
            const int r = rr[q];
            if (r >= TL && cmode != 0 && (q == 0 || has1)) {
                if (cmode == 2) {
                    for (int c = 0; c < nch; ++c) {
                        const float* pp = P + ((size_t)c * 512 + (r - TL)) * DM;
#pragma unroll
                        for (int i = 0; i < 4; ++i) x[q][i] += *(const f32x4*)(pp + i * 256 + lane * 4);
                    }
                }
#pragma unroll
                for (int i = 0; i < 4; ++i) *(f32x4*)(xs + (size_t)r * DM + i * 256 + lane * 4) = x[q][i];
            }
#pragma unroll
            for (int i = 0; i < 4; ++i) ss[q] += x[q][i][0] * x[q][i][0] + x[q][i][1] * x[q][i][1] + x[q][i][2] * x[q][i][2] + x[q][i][3] * x[q][i][3];
            ss[q] = wave_sum(ss[q], lane);
        }
#pragma unroll
        for (int q = 0; q < 2; ++q) {
            if (q == 1 && !has1) break;
            const int r = rr[q];
            const int v = r < SEQ ? 0 : (r < TL ? 1 : 2);
            const float* sh = modl + v * 9216 + si * 1024; const float* sc = modl + v * 9216 + ci * 1024;
            const float rs = rsqrtf(ss[q] * (1.0f / 1024.0f) + 1e-6f);
#pragma unroll
            for (int i = 0; i < 4; ++i) {
                const f32x4 s4 = *(const f32x4*)(sc + i * 256 + lane * 4), h4 = *(const f32x4*)(sh + i * 256 + lane * 4);
                const f32x4 y = x[q][i] * rs * (s4 + 1.0f) + h4;
                u32x2 w; w.x = cvt_pk_bf16(y[0], y[1]); w.y = cvt_pk_bf16(y[2], y[3]);
                *(u32x2*)(h + (size_t)r * DM + i * 256 + lane * 4) = w;
            }
        }
    }
}
__device__ void final_phase(const float* xs, const float* fn, float* out) {
    const int tid = otid(), wid = tid >> 6, lane = tid & 63;
    const int nw = gridDim.x * 8;
    for (int r0 = blockIdx.x * 8 + wid; r0 < TL; r0 += 2 * nw) {
        const int r1 = r0 + nw; const bool has1 = r1 < TL;
        const int rr[2] = {r0, has1 ? r1 : r0};
        f32x4 x[2][4]; float ss[2] = {0.f, 0.f};
#pragma unroll
        for (int q = 0; q < 2; ++q)
#pragma unroll
            for (int i = 0; i < 4; ++i) x[q][i] = *(const f32x4*)(xs + (size_t)rr[q] * DM + i * 256 + lane * 4);
#pragma unroll
        for (int q = 0; q < 2; ++q) {
#pragma unroll
            for (int i = 0; i < 4; ++i) ss[q] += x[q][i][0] * x[q][i][0] + x[q][i][1] * x[q][i][1] + x[q][i][2] * x[q][i][2] + x[q][i][3] * x[q][i][3];
            ss[q] = wave_sum(ss[q], lane);
        }
#pragma unroll
        for (int q = 0; q < 2; ++q) {
            if (q == 1 && !has1) break;
            const float rs = rsqrtf(ss[q] * (1.0f / 1024.0f) + 1e-6f);
#pragma unroll
            for (int i = 0; i < 4; ++i) { const f32x4 w4 = *(const f32x4*)(fn + i * 256 + lane * 4);
                __builtin_nontemporal_store(x[q][i] * rs * w4, (f32x4*)(out + (size_t)rr[q] * DM + i * 256 + lane * 4)); }
        }
    }
}

constexpr int AT_STAGE = 9216 + 9216, AT_RPB = 3 * AT_STAGE;
template <bool NOMAX>
__device__ __forceinline__ void attn_item(char* lds, const bf16_t* Qp, const bf16_t* Kp, const bf16_t* VTp, int ldv, int ntiles, bf16_t* Op, int ldo) {
    const int tid = otid(), wid = __builtin_amdgcn_readfirstlane(tid >> 6), lane = tid & 63;
    const int lr = lane & 31, lh = lane >> 5;
    bf16x8 qf[4];
#pragma unroll
    for (int kk = 0; kk < 4; ++kk) qf[kk] = *(const bf16x8*)(Qp + (size_t)(32 * wid + lr) * 64 + 16 * kk + 8 * lh);
    f32x16 o[2];
#pragma unroll
    for (int b = 0; b < 2; ++b)
#pragma unroll
        for (int i = 0; i < 16; ++i) o[b][i] = 0.f;
    float mrun = -1e30f, lrun = 0.f;
    u32x4 kreg, vreg;
    const bf16_t* kgp = Kp + tid * 8; const bf16_t* vgp = VTp + (size_t)(tid >> 3) * ldv + (tid & 7) * 8;
    const int kls = (tid >> 3) * 144 + (tid & 7) * 16, vls = 9216 + (tid >> 3) * 144 + (tid & 7) * 16;
    const int kfo = lr * 144 + lh * 16, vfo = 9216 + lr * 144 + lh * 16;
#define AT_SCHED __builtin_amdgcn_sched_barrier(0)
#define AT_GLOAD(t_) do { kreg = *(const u32x4*)(kgp + (size_t)(t_) * 4096); vreg = *(const u32x4*)(vgp + (t_) * 64); } while (0)
#define AT_LSTORE(s_) do { *(u32x4*)(lds + (s_) * AT_STAGE + kls) = kreg; *(u32x4*)(lds + (s_) * AT_STAGE + vls) = vreg; } while (0)
#define AT_KLOAD(KF, st_, kb_) do { const char* Ks_ = lds + (st_) * AT_STAGE + kfo + (kb_) * 4608; \
        _Pragma("unroll") for (int kk = 0; kk < 4; ++kk) KF[kk] = *(const bf16x8*)(Ks_ + kk * 32); } while (0)
#define AT_QKMMA(S, KF) do { \
        _Pragma("unroll") for (int i = 0; i < 16; ++i) S[i] = 0.f; \
        _Pragma("unroll") for (int kk = 0; kk < 4; ++kk) S = __builtin_amdgcn_mfma_f32_32x32x16_bf16(KF[kk], qf[kk], S, 0, 0, 0); } while (0)
#define AT_VLOAD(VF, st_, kb_) do { const char* Vs_ = lds + (st_) * AT_STAGE + vfo + (kb_) * 64; \
        _Pragma("unroll") for (int sl = 0; sl < 2; ++sl) _Pragma("unroll") for (int db = 0; db < 2; ++db) VF[sl][db] = *(const bf16x8*)(Vs_ + db * 4608 + sl * 32); } while (0)
#define AT_PVMMA(VF, PF) do { \
        _Pragma("unroll") for (int sl = 0; sl < 2; ++sl) _Pragma("unroll") for (int db = 0; db < 2; ++db) \
            o[db] = __builtin_amdgcn_mfma_f32_32x32x16_bf16(VF[sl][db], PF[sl], o[db], 0, 0, 0); } while (0)
#define AT_PACK(PF, S) do { _Pragma("unroll") for (int sl = 0; sl < 2; ++sl) { \
            u32x4 w_; w_.x = cvt_pk_bf16(S[8 * sl + 0], S[8 * sl + 1]); w_.y = cvt_pk_bf16(S[8 * sl + 2], S[8 * sl + 3]); \
            w_.z = cvt_pk_bf16(S[8 * sl + 4], S[8 * sl + 5]); w_.w = cvt_pk_bf16(S[8 * sl + 6], S[8 * sl + 7]); PF[sl] = __builtin_bit_cast(bf16x8, w_); } } while (0)
#define AT_STEP(SC, SN, T, HASN) do { const int t_ = (T); \
        constexpr bool hasn_ = HASN; \
        if (t_ + 2 < ntiles) AT_GLOAD(t_ + 2); \
        bf16x8 kfa_[4], kfb_[4]; bf16x8 vf0_[2][2], vf1_[2][2]; bf16x8 pf0_[2], pf1_[2]; \
        if (hasn_) AT_KLOAD(kfa_, sn, 0); \
        AT_SCHED; \
        if (hasn_) { AT_KLOAD(kfb_, sn, 1); AT_SCHED; AT_QKMMA(SN[0], kfa_); } \
        AT_VLOAD(vf0_, sc, 0); \
        AT_SCHED; \
        if (hasn_) AT_QKMMA(SN[1], kfb_); \
        AT_SCHED; \
        { \
            if constexpr (!NOMAX) { \
            float mx_ = max3f(SC[0][0], SC[1][0], SC[0][1]), my_ = max3f(SC[1][1], SC[0][2], SC[1][2]); \
            _Pragma("unroll") for (int i = 3; i < 15; i += 2) { mx_ = max3f(mx_, SC[0][i], SC[1][i]); my_ = max3f(my_, SC[0][i + 1], SC[1][i + 1]); } \
            mx_ = max3f(mx_, SC[0][15], SC[1][15]); mx_ = fmaxf(mx_, my_); \
            mx_ = fmaxf(mx_, shx32(mx_, lane)); \
            if (__builtin_amdgcn_ballot_w64(mx_ > mrun) != 0ull) { \
                const float mn_ = fmaxf(mrun, mx_); \
                const float alpha_ = fexp2(mrun - mn_); \
                mrun = mn_; \
                lrun *= alpha_; \
                _Pragma("unroll") for (int db = 0; db < 2; ++db) \
                _Pragma("unroll") for (int i = 0; i < 16; ++i) o[db][i] *= alpha_; \
            } \
            _Pragma("unroll") for (int kb = 0; kb < 2; ++kb) \
            _Pragma("unroll") for (int i = 0; i < 16; ++i) SC[kb][i] -= mrun; \
            } \
            float sum0_ = 0.f, sum1_ = 0.f, sum2_ = 0.f, sum3_ = 0.f; \
            _Pragma("unroll") for (int i = 0; i < 16; i += 4) { SC[0][i] = fexp2(SC[0][i]); SC[0][i + 1] = fexp2(SC[0][i + 1]); SC[0][i + 2] = fexp2(SC[0][i + 2]); SC[0][i + 3] = fexp2(SC[0][i + 3]); \
                sum0_ += SC[0][i]; sum1_ += SC[0][i + 1]; sum2_ += SC[0][i + 2]; sum3_ += SC[0][i + 3]; } \
            AT_PACK(pf0_, SC[0]); \
            AT_SCHED; \
            AT_VLOAD(vf1_, sc, 1); \
            AT_PVMMA(vf0_, pf0_); \
            AT_SCHED; \
            _Pragma("unroll") for (int i = 0; i < 16; i += 4) { SC[1][i] = fexp2(SC[1][i]); SC[1][i + 1] = fexp2(SC[1][i + 1]); SC[1][i + 2] = fexp2(SC[1][i + 2]); SC[1][i + 3] = fexp2(SC[1][i + 3]); \
                sum0_ += SC[1][i]; sum1_ += SC[1][i + 1]; sum2_ += SC[1][i + 2]; sum3_ += SC[1][i + 3]; } \
            lrun += (sum0_ + sum1_) + (sum2_ + sum3_); \
            AT_PACK(pf1_, SC[1]); \
            AT_SCHED; \
            AT_PVMMA(vf1_, pf1_); \
        } \
        if (t_ + 2 < ntiles) AT_LSTORE(sp); \
        { const int tmp_ = sc; sc = sn; sn = sp; sp = tmp_; } \
        __syncthreads(); } while (0)
    int sc = 0, sn = 1, sp = 2;
    AT_GLOAD(0); AT_LSTORE(0);
    if (ntiles > 1) { AT_GLOAD(1); AT_LSTORE(1); }
    __syncthreads();
    f32x16 sa[2], sb[2];
    { bf16x8 kfa_[4], kfb_[4]; AT_KLOAD(kfa_, 0, 0); AT_KLOAD(kfb_, 0, 1); AT_QKMMA(sa[0], kfa_); AT_QKMMA(sa[1], kfb_); }
    for (int t = 0; t < ntiles - 2; t += 2) {
        AT_STEP(sa, sb, t, true);
        AT_STEP(sb, sa, t + 1, true);
    }
    AT_STEP(sa, sb, ntiles - 2, true);
    AT_STEP(sb, sa, ntiles - 1, false);
#undef AT_GLOAD
#undef AT_LSTORE
#undef AT_KLOAD
#undef AT_QKMMA
#undef AT_VLOAD
#undef AT_PVMMA
#undef AT_PACK
#undef AT_SCHED
#undef AT_STEP
    {
        float l = lrun + shx32(lrun, lane);
        const float inv = 1.0f / l;
        bf16_t* orow = Op + (size_t)(32 * wid + lr) * ldo;
#pragma unroll
        for (int db = 0; db < 2; ++db)
#pragma unroll
            for (int i4 = 0; i4 < 4; ++i4) {
                u32x2 w; w.x = cvt_pk_bf16(o[db][i4 * 4 + 0] * inv, o[db][i4 * 4 + 1] * inv); w.y = cvt_pk_bf16(o[db][i4 * 4 + 2] * inv, o[db][i4 * 4 + 3] * inv);
                *(u32x2*)(orow + 32 * db + 8 * i4 + 4 * lh) = w;
            }
    }
}

template <bool NA, bool NOMAX>
__device__ __forceinline__ void attn_item_na(char* lds, const bf16_t* Qp, const bf16_t* Kp, const bf16_t* VTp, int ldv, int ntiles, int toff,
                                          bf16_t* Op, int ldo, int na_r0, int na_rs0) {
    const int tid = otid(), wid = __builtin_amdgcn_readfirstlane(tid >> 6), lane = tid & 63;
    const int lr = lane & 31, lh = lane >> 5;
    const float* rpbs = (const float*)(lds + AT_RPB);
    bf16x8 qf[4];
#pragma unroll
    for (int kk = 0; kk < 4; ++kk) qf[kk] = *(const bf16x8*)(Qp + (size_t)(32 * wid + lr) * 64 + 16 * kk + 8 * lh);
    f32x16 o[2];
#pragma unroll
    for (int b = 0; b < 2; ++b)
#pragma unroll
        for (int i = 0; i < 16; ++i) o[b][i] = 0.f;
    float mrun = -1e30f, lrun = 0.f;
    u32x4 kreg, vreg;
    const int na_r = na_r0 + (wid >> 1);
    const int na_rs = min(max(na_r - 4, 0), 120);
    const int na_c = 32 * (wid & 1) + lr, na_cst = min(max(na_c - 8, 0), 48);
    float madd[2][16];
    if (NA) {
#pragma unroll
        for (int kb = 0; kb < 2; ++kb)
#pragma unroll
            for (int i = 0; i < 16; ++i) { const int kc = 32 * kb + (i & 3) + 8 * (i >> 2) + 4 * lh; madd[kb][i] = (unsigned)(kc - na_cst) < 16u ? 0.f : -1e30f; }
    }
#define AT_GLOAD(t_) do { const int kt_ = (t_) < 4 ? (t_) : (t_) + toff; \
        kreg = *(const u32x4*)(Kp + (size_t)kt_ * 4096 + tid * 8); vreg = *(const u32x4*)(VTp + (size_t)(tid >> 3) * ldv + kt_ * 64 + (tid & 7) * 8); } while (0)
#define AT_LSTORE(s_) do { *(u32x4*)(lds + (s_) * AT_STAGE + (tid >> 3) * 144 + (tid & 7) * 16) = kreg; *(u32x4*)(lds + (s_) * AT_STAGE + 9216 + (tid >> 3) * 144 + (tid & 7) * 16) = vreg; } while (0)
    AT_GLOAD(0); AT_LSTORE(0);
    __syncthreads();
    for (int t = 0; t < ntiles; ++t) {
        if (t + 1 < ntiles) AT_GLOAD(t + 1);
        bool active = true;
        int kr = 0;
        if (NA) { kr = na_rs0 + t - 4; if (t >= 4 && (kr < na_rs || kr >= na_rs + 8)) active = false; }
        if (active) {
            const char* Ks = lds + (t & 1) * AT_STAGE; const char* Vs = Ks + 9216;
            f32x16 s[2];
#pragma unroll
            for (int kb = 0; kb < 2; ++kb) {
#pragma unroll
                for (int i = 0; i < 16; ++i) s[kb][i] = 0.f;
#pragma unroll
                for (int kk = 0; kk < 4; ++kk) {
                    const bf16x8 kf = *(const bf16x8*)(Ks + (32 * kb + lr) * 144 + (16 * kk + 8 * lh) * 2);
                    s[kb] = __builtin_amdgcn_mfma_f32_32x32x16_bf16(kf, qf[kk], s[kb], 0, 0, 0);
                }
            }
            if (NA && t >= 4) {
                const float* rb = rpbs + 64 + (kr - na_r + 7) * 31 + 15 - na_c + 4 * lh;
#pragma unroll
                for (int kb = 0; kb < 2; ++kb)
#pragma unroll
                    for (int i = 0; i < 16; ++i) s[kb][i] = (s[kb][i] + rb[32 * kb + (i & 3) + 8 * (i >> 2)]) + madd[kb][i];
            }
            if constexpr (NOMAX) {
                float sum = 0.f;
#pragma unroll
                for (int kb = 0; kb < 2; ++kb)
#pragma unroll
                    for (int i = 0; i < 16; ++i) { s[kb][i] = fexp2(s[kb][i]); sum += s[kb][i]; }
                lrun += sum;
            } else {
                float mx = s[0][0];
    #pragma unroll
                for (int i = 1; i < 16; ++i) mx = fmaxf(mx, s[0][i]);
    #pragma unroll
                for (int i = 0; i < 16; ++i) mx = fmaxf(mx, s[1][i]);
                mx = fmaxf(mx, shx32(mx, lane));
                const float mn = fmaxf(mrun, mx), alpha = fexp2(mrun - mn);
                mrun = mn;
                float sum = 0.f;
    #pragma unroll
                for (int kb = 0; kb < 2; ++kb)
    #pragma unroll
                    for (int i = 0; i < 16; ++i) { s[kb][i] = fexp2(s[kb][i] - mn); sum += s[kb][i]; }
                lrun = lrun * alpha + sum;
    #pragma unroll
                for (int db = 0; db < 2; ++db)
    #pragma unroll
                    for (int i = 0; i < 16; ++i) o[db][i] *= alpha;
            }
#pragma unroll
            for (int kb = 0; kb < 2; ++kb)
#pragma unroll
                for (int sl = 0; sl < 2; ++sl) {
                    u32x4 w; w.x = cvt_pk_bf16(s[kb][8 * sl + 0], s[kb][8 * sl + 1]); w.y = cvt_pk_bf16(s[kb][8 * sl + 2], s[kb][8 * sl + 3]);
                    w.z = cvt_pk_bf16(s[kb][8 * sl + 4], s[kb][8 * sl + 5]); w.w = cvt_pk_bf16(s[kb][8 * sl + 6], s[kb][8 * sl + 7]);
                    const bf16x8 pf = __builtin_bit_cast(bf16x8, w);
#pragma unroll
                    for (int db = 0; db < 2; ++db) {
                        const bf16x8 vf = *(const bf16x8*)(Vs + (32 * db + lr) * 144 + (32 * kb + 16 * sl + 8 * lh) * 2);
                        o[db] = __builtin_amdgcn_mfma_f32_32x32x16_bf16(vf, pf, o[db], 0, 0, 0);
                    }
                }
        }
        if (t + 1 < ntiles) AT_LSTORE((t + 1) & 1);
        __syncthreads();
    }
#undef AT_GLOAD
#undef AT_LSTORE
    {
        float l = lrun + shx32(lrun, lane);
        const float inv = 1.0f / l;
        bf16_t* orow = Op + (size_t)(32 * wid + lr) * ldo;
#pragma unroll
        for (int db = 0; db < 2; ++db)
#pragma unroll
            for (int i4 = 0; i4 < 4; ++i4) {
                u32x2 w; w.x = cvt_pk_bf16(o[db][i4 * 4 + 0] * inv, o[db][i4 * 4 + 1] * inv); w.y = cvt_pk_bf16(o[db][i4 * 4 + 2] * inv, o[db][i4 * 4 + 3] * inv);
                *(u32x2*)(orow + 32 * db + 8 * i4 + 4 * lh) = w;
            }
    }
}

__device__ void fft_item(char* lds, const float* Z, int row0, int N, int logN, int col, bf16_t* cat, float scale) {
    const int tid = otid();
    f32x2* x = (f32x2*)lds;
    const f32x2* tw = (const f32x2*)(lds + 65536);
    if (N == 8192) {
        f32x2 z[16];
#pragma unroll
        for (int u = 0; u < 16; ++u) z[u] = *(const f32x2*)(Z + (size_t)(row0 + tid + 512 * u) * 512 + col * 2);
#pragma unroll
        for (int u = 0; u < 16; ++u) x[tid + 512 * u] = z[u];
    } else {
        for (int i = tid; i < N; i += 512) x[i] = *(const f32x2*)(Z + (size_t)(row0 + i) * 512 + col * 2);
    }
    __syncthreads();
    for (int lh = logN - 1; lh >= 0; --lh) {
        const int half = 1 << lh, twsh = 12 - lh;
        if (N == 8192) {
            f32x2 a[8], b[8], w[8]; int ia[8];
#pragma unroll
            for (int u = 0; u < 8; ++u) { const int j = tid + 512 * u, pos = j & (half - 1); ia[u] = ((j >> lh) << (lh + 1)) + pos; a[u] = x[ia[u]]; b[u] = x[ia[u] + half]; w[u] = tw[pos << twsh]; }
#pragma unroll
            for (int u = 0; u < 8; ++u) { const f32x2 d = a[u] - b[u]; x[ia[u]] = a[u] + b[u]; x[ia[u] + half] = (f32x2){d.x * w[u].x - d.y * w[u].y, d.x * w[u].y + d.y * w[u].x}; }
        } else {
            for (int j = tid; j < (N >> 1); j += 512) {
                const int pos = j & (half - 1), i0 = ((j >> lh) << (lh + 1)) + pos, i1 = i0 + half;
                const f32x2 a = x[i0], b = x[i1], w = tw[pos << twsh];
                const f32x2 d = a - b;
                x[i0] = a + b;
                x[i1] = (f32x2){d.x * w.x - d.y * w.y, d.x * w.y + d.y * w.x};
            }
        }
        __syncthreads();
    }
    for (int i = tid; i < N; i += 512) { const int k = (int)(__brev((unsigned)i) >> (32 - logN)); cat[(size_t)(row0 + k) * DM + 768 + col] = f2bf(x[i].x * scale); }
    __syncthreads();
}

__device__ void mix_ab_phase(PP pp, char* lds) {
    const int tid = otid(), bid = blockIdx.x;
    char* ws = pp->ws;
    bf16_t* cat = (bf16_t*)(ws + OFF_H);
    const float* Z = (const float*)(ws + A_Z);
    { f32x2* tw = (f32x2*)(lds + 65536);
      for (int j = tid; j < 4096; j += 512) { float s, c; sincospif((float)j / 4096.0f, &s, &c); tw[j] = (f32x2){c, -s}; } }
    __syncthreads();
    for (int ci = bid; ci < 1024; ci += gridDim.x) {
        int idx = ci & 511; const bool isctx = ci >= 512;
        if (gridDim.x == 256) idx = (bid & 7) * 64 + (bid >> 3) * 2 + ((ci >> 8) & 1);
        const int b = idx >> 8, col = idx & 255;
        if (!isctx) fft_item(lds, Z, b * SEQ, SEQ, 13, col, cat, 0.001381067932f  );
        else fft_item(lds, Z, TL + b * CTXL, CTXL, 8, col, cat, 0.0078125f  );
    }
    bool nomax;
    { float mq = 0.f, mk = 0.f;
      for (int i = 0; i < 64; ++i) { mq = fmaxf(mq, fabsf(pp->in[11][i])); mk = fmaxf(mk, fabsf(pp->in[12][i])); }
      const float bound = 64.0f * mq * mk * QSCALE;
      nomax = bound < 64.0f; }
    const bf16_t* Q = (const bf16_t*)(ws + A_Q); const bf16_t* QC = (const bf16_t*)(ws + A_QC);
    const bf16_t* Kall = (const bf16_t*)(ws + A_KALL); const bf16_t* VT = (const bf16_t*)(ws + A_VTALL);
    for (int it = bid; it < 24; it += gridDim.x) {
        const int b = it / 12, h = it % 12, kvh = h / 3;
        if (nomax) attn_item<true>(lds, QC + (size_t)(b * 12 + h) * CTXL * 64, Kall + (size_t)(b * 4 + kvh) * NKEY * 64, VT + (size_t)(b * 4 + kvh) * 64 * NKEY, NKEY, 4,
                  cat + (size_t)(TL + b * CTXL) * DM + h * 64, DM);
        else attn_item<false>(lds, QC + (size_t)(b * 12 + h) * CTXL * 64, Kall + (size_t)(b * 4 + kvh) * NKEY * 64, VT + (size_t)(b * 4 + kvh) * 64 * NKEY, NKEY, 4,
                  cat + (size_t)(TL + b * CTXL) * DM + h * 64, DM);
    }
    for (int e = bid; e < 768; e += gridDim.x) {
        int g, qb, bk;
        if (gridDim.x == 256) {
            bk = bid & 7;
            const int idx = (bid >> 3) * 3 + (e >> 8); g = idx % 3; qb = idx / 3;
        } else { g = e % 3; const int r1 = e / 3; qb = r1 & 31; bk = r1 >> 5; }
        const int b = bk >> 2, kvh = bk & 3, h = kvh * 3 + g;
        if (nomax) attn_item<true>(lds, Q + ((size_t)(b * 12 + h) * SEQ + qb * 256) * 64, Kall + (size_t)bk * NKEY * 64, VT + (size_t)bk * 64 * NKEY, NKEY, 132,
                  cat + (size_t)(b * SEQ + qb * 256) * DM + h * 64, DM);
        else attn_item<false>(lds, Q + ((size_t)(b * 12 + h) * SEQ + qb * 256) * 64, Kall + (size_t)bk * NKEY * 64, VT + (size_t)bk * 64 * NKEY, NKEY, 132,
                  cat + (size_t)(b * SEQ + qb * 256) * DM + h * 64, DM);
    }
}

__device__ void conv_item(PP pp, char* lds, int item) {
    const int tid = otid(), wid = tid >> 6, lane = tid & 63;
    const bf16_t* U = (const bf16_t*)(pp->ws + A_U);
    bf16_t* cat2 = (bf16_t*)(pp->ws + OFF_H);
    bf16_t* ut = (bf16_t*)lds;
    float* yt = (float*)(lds + 63488);
    const int t0 = item * 32, b = t0 >> 13, n0 = t0 & 8191;
    for (int c = tid; c < 62 * 64; c += 512) {
        const int rr = c >> 6, part = c & 63, n = n0 - 15 + rr;
        u32x4 v = (u32x4){0u, 0u, 0u, 0u};
        if (n >= 0 && n < SEQ) v = *(const u32x4*)(U + ((size_t)(b * SEQ + n)) * 512 + part * 8);
        *(u32x4*)(ut + rr * 512 + part * 8) = v;
    }
    float w[31];
#pragma unroll
    for (int j = 0; j < 31; ++j) w[j] = pp->in[15][j * 512 + tid];
    const float bias = pp->in[16][tid];
    __syncthreads();
#pragma unroll 1
    for (int tg = 0; tg < 4; ++tg) {
        float y[8];
#pragma unroll
        for (int t = 0; t < 8; ++t) y[t] = bias;
#pragma unroll
        for (int i = 0; i < 38; ++i) {
            const float uv = bf2f(ut[(tg * 8 + i) * 512 + tid]);
#pragma unroll
            for (int t = 0; t < 8; ++t) { const int j = i - t; if (j >= 0 && j < 31) y[t] += uv * w[j]; }
        }
#pragma unroll
        for (int t = 0; t < 8; ++t) yt[(tg * 8 + t) * 516 + tid] = y[t];
    }
    __syncthreads();
    const float* lw = pp->in[17]; const float* lb = pp->in[18];
#pragma unroll 1
    for (int q = 0; q < 4; ++q) {
        const int tok = wid * 4 + q;
        const f32x4 a = *(const f32x4*)(yt + tok * 516 + lane * 8), c = *(const f32x4*)(yt + tok * 516 + lane * 8 + 4);
        float s = a[0] + a[1] + a[2] + a[3] + c[0] + c[1] + c[2] + c[3];
        s = wave_sum(s, lane);
        const float mu = s * (1.0f / 512.0f);
        const f32x4 da = a - mu, dc = c - mu;
        float vs = da[0] * da[0] + da[1] * da[1] + da[2] * da[2] + da[3] * da[3] + dc[0] * dc[0] + dc[1] * dc[1] + dc[2] * dc[2] + dc[3] * dc[3];
        vs = wave_sum(vs, lane);
        const float rs = rsqrtf(vs * (1.0f / 512.0f) + 1e-6f);
        const f32x4 w0 = *(const f32x4*)(lw + lane * 8), w1 = *(const f32x4*)(lw + lane * 8 + 4), b0 = *(const f32x4*)(lb + lane * 8), b1 = *(const f32x4*)(lb + lane * 8 + 4);
        f32x4 y0 = da * rs * w0 + b0, y1 = dc * rs * w1 + b1;
#pragma unroll
        for (int j = 0; j < 4; ++j) { y0[j] = siluf_(y0[j]); y1[j] = siluf_(y1[j]); }
        u32x4 o; o.x = cvt_pk_bf16(y0[0], y0[1]); o.y = cvt_pk_bf16(y0[2], y0[3]); o.z = cvt_pk_bf16(y1[0], y1[1]); o.w = cvt_pk_bf16(y1[2], y1[3]);
        *(u32x4*)(cat2 + (size_t)(t0 + tok) * DM + lane * 8) = o;
    }
    __syncthreads();
}
__device__ void mix_cd_phase(PP pp, char* lds) {
    const int tid = otid(), bid = blockIdx.x;
    char* ws = pp->ws;
    for (int it = bid; it < 512; it += gridDim.x) conv_item(pp, lds, it);
    bool nomax;
    { float bm = 0.f;
      for (int i = tid; i < 8 * 527; i += 512) bm = fmaxf(bm, fabsf(pp->in[19][i]));
      bm = fmaxf(bm, shx32(bm, tid & 63)); bm = fmaxf(bm, shx<16>(bm)); bm = fmaxf(bm, shx<8>(bm)); bm = fmaxf(bm, shx<4>(bm)); bm = fmaxf(bm, shx<2>(bm)); bm = fmaxf(bm, shx<1>(bm));
      float* red = (float*)(lds + 130048);
      if ((tid & 63) == 0) red[tid >> 6] = bm;
      __syncthreads();
      float bb = red[0];
      for (int i = 1; i < 8; ++i) bb = fmaxf(bb, red[i]);
      const unsigned* bw = (const unsigned*)(ws + OFF_BAR);
      const float q2 = __uint_as_float(bw[3600]), k2 = __uint_as_float(bw[3664]);
      const float bound = sqrtf(q2) * sqrtf(k2) * QSCALE * 1.02f + bb * LOG2E;
      nomax = bound < 64.0f;
      __syncthreads(); }
    const bf16_t* QN = (const bf16_t*)(ws + A_QN); const bf16_t* Kna = (const bf16_t*)(ws + A_KNA); const bf16_t* VT = (const bf16_t*)(ws + A_VTNA);
    bf16_t* cat2 = (bf16_t*)(ws + OFF_H);
    for (int it = bid; it < 512; it += gridDim.x) {
        int h, rb, b;
        if (gridDim.x == 256) { const int bh = (bid & 7) + 8 * (it >> 8); b = bh >> 3; h = bh & 7; rb = bid >> 3; }
        else { h = it & 7; rb = (it >> 3) & 31; b = it >> 8; }
        const int r0 = rb * 4;
        const int rs0 = min(max(r0 - 4, 0), 120), rs3 = min(max(r0 + 3 - 4, 0), 120);
        const int ntiles = 4 + (rs3 + 8 - rs0);
        float* rpbs = (float*)(lds + AT_RPB);
        for (int i = tid; i < 64 + 527 + 64; i += 512) rpbs[i] = (i >= 64 && i < 64 + 527) ? pp->in[19][h * 527 + i - 64] * LOG2E : 0.f;
        const bf16_t* qp = QN + ((size_t)(b * 8 + h) * SEQ + r0 * 64) * 64; const bf16_t* kp = Kna + (size_t)(b * 8 + h) * NKEY * 64; const bf16_t* vp = VT + (size_t)(b * 8 + h) * 64 * NKEY;
        bf16_t* op = cat2 + (size_t)(b * SEQ + r0 * 64) * DM + 512 + h * 64;
        if (nomax) attn_item_na<true, true>(lds, qp, kp, vp, NKEY, ntiles, rs0, op, DM, r0, rs0);
        else attn_item_na<true, false>(lds, qp, kp, vp, NKEY, ntiles, rs0, op, DM, r0, rs0);
    }
}

constexpr int NSTEPS = 22;
#define ST(op, a0, a1) ((op) | ((a0) << 4) | ((a1) << 8))
#define STN(a0, a1, nch) (1 | ((a0) << 4) | ((a1) << 8) | ((nch) << 12))
__constant__ int STEP_TAB[NSTEPS] = {
    ST(0, 0, 0),
    STN(0, 1, 0), ST(2, 0, 0), ST(3, 0, 2), STN(3, 4, 11), ST(4, 0, 0), ST(6, 0, 0), ST(3, 2, 5), STN(6, 7, 4), ST(2, 1, 0), ST(3, 1, 8),
    STN(0, 1, 11), ST(2, 0, 0), ST(3, 0, 2), STN(3, 4, 11), ST(4, 0, 0), ST(6, 0, 0), ST(3, 2, 5), STN(6, 7, 0), ST(2, 1, 0), ST(3, 1, 8),
    ST(7, 0, 0)};
__global__ void __launch_bounds__(512, 2) fwd_megakernel(Params p, int s0, int s1) {
    extern __shared__ __attribute__((aligned(16))) unsigned char shm[];
    char* lds = (char*)shm;
    volatile LAS unsigned* bst = (volatile LAS unsigned*)((LAS unsigned char*)shm + 131072);
    if (threadIdx.x == 0) { bst[0] = 0u; bst[1] = 0u; bst[2] = 0u; bst[3] = 0u; }
    __syncthreads();
    XcdBarrier gbar;
    { PP pp0 = (PP)__builtin_amdgcn_kernarg_segment_ptr(); gbar = xcd_barrier_post((unsigned*)(pp0->ws + OFF_BAR), bst); }
    if (s1 > 1000) cg::this_grid().sync();
#ifndef DUP_MASK
#define DUP_MASK 0u
#endif
    for (int sidx = s0; sidx < s1 + (int)__builtin_popcount(DUP_MASK); ++sidx) {
        if (sidx > s0) xcd_barrier(gbar);
        int step = sidx;
        if (DUP_MASK != 0u) { int acc = 0; step = 0; for (int q = 0; q < NSTEPS; ++q) { const int reps = 1 + (int)((DUP_MASK >> q) & 1u); if (sidx >= acc && sidx < acc + reps) step = q; acc += reps; } }
        PP pp = (PP)__builtin_amdgcn_kernarg_segment_ptr();
        asm volatile("" : "+s"(pp));
        char* ws = pp->ws;
        float* xs = (float*)(ws + OFF_XS);
        bf16_t* hbuf = (bf16_t*)(ws + OFF_H);
        bf16_t* act = (bf16_t*)(ws + OFF_A);
        const float* mod = (const float*)(ws + OFF_MOD);
        const int layer = step >= 11 ? 1 : 0;
        const float* modl = mod + layer * 3 * 9216;
        const int code = STEP_TAB[step];
        const int op = code & 15, a0 = (code >> 4) & 15, a1 = (code >> 8) & 15, nch = (code >> 12) & 15;
        const bool tail = step >= 17;
        const int Mrows = tail ? TL : TT;
        if (op == 0) prep_phase(pp, lds);
        else if (op == 1) {
            const bool first = step == 1;
            norm_phase(first ? pp->in[0] : xs, first ? pp->in[2] : xs + (size_t)TL * DM, Mrows, modl, a0, a1, hbuf, first ? 1 : (nch ? 2 : 0), nch, xs, (const float*)(ws + OFF_P));
        } else if (op == 2) {
            pg8::Gemm g{hbuf, (const bf16_t*)(ws + OFF_W1T + (size_t)(layer * 2 + a0) * SZ_W1T), Mrows, 5632, 1024};
            pg8::StaticOrder S; S.init(g.M, g.N, g.K, (int)gridDim.x, (int)blockIdx.x, false);
            EpiSwiglu E{act};
            pg8::gemm_phase(( LAS unsigned char*)shm, g, S, E);
            if (gridDim.x == 256 && blockIdx.x >= 172) {
                if (step == 2) transpose_tiles(pp, lds, 11, (int)blockIdx.x - 172, 84, 2432);
                if (step == 9) transpose_tiles(pp, lds, 13, (int)blockIdx.x - 172, 84, 2112);
                if (step == 12) transpose_tiles(pp, lds, 14, (int)blockIdx.x - 172, 84, 2048);
            }
        } else if (op == 3) {
            const bool mixout = a0 == 2, first = step == 3;
            const bf16_t* Bw = (const bf16_t*)(ws + (mixout ? (layer == 0 ? OFF_ABOUT : OFF_CDOUT) : OFF_W2T + (size_t)(layer * 2 + a0) * SZ_W2T));
            const pg8::Gemm g{mixout ? hbuf   : act, Bw, Mrows, 1024, mixout ? 1024 : 2816};
            const float* xl = first ? pp->in[0] : xs; const float* xc = first ? pp->in[2] - (size_t)TL * DM : xs;
            const EpiResid E{xl, xc, ws, layer * 3 * 9216 + a1 * 1024, mixout ? 1 : 0};
            pg8::StaticOrder S; S.init(g.M, g.N, g.K, (int)gridDim.x, (int)blockIdx.x, !tail);
            pg8::gemm_phase((LAS unsigned char*)shm, g, S, E);
        } else if (op == 4) {
            const bool l0 = layer == 0;
            pg8::Gemm g{hbuf, (const bf16_t*)(ws + (l0 ? OFF_ABIN : OFF_CDIN)), TT, l0 ? 1792 : 2560, 1024};
            pg8::StaticOrder S; S.init(g.M, g.N, g.K, (int)gridDim.x, (int)blockIdx.x, false);
            const EpiMixIn E{layer, ws, pp->in[11], pp->in[12]};
            pg8::gemm_phase((LAS unsigned char*)shm, g, S, E);
            if (gridDim.x == 256) {
                if (layer == 0 && blockIdx.x >= 206) transpose_tiles(pp, lds, 12, (int)blockIdx.x - 206, 50, 960);
                if (layer == 1 && blockIdx.x >= 148) transpose_tiles(pp, lds, 15, (int)blockIdx.x - 148, 108, 960);
            }
        } else if (op == 6) {
            if (layer == 0) mix_ab_phase(pp, lds); else mix_cd_phase(pp, lds);
        } else {
            final_phase(xs, pp->in[20], pp->out);
        }
    }
}

extern "C" void kernel_launch(void* const* d_in, const int* in_sizes, int n_in, void* d_out, int out_size, void* d_ws, size_t ws_size, hipStream_t stream) {
    static int grid_blocks = 0;
    if (!grid_blocks) {
        int dev = 0, cus = 0, per_cu = 0;
        hipGetDevice(&dev);
        hipDeviceGetAttribute(&cus, hipDeviceAttributeMultiprocessorCount, dev);
        hipFuncSetAttribute((const void*)fwd_megakernel, hipFuncAttributeMaxDynamicSharedMemorySize, LDS_BYTES);
        hipOccupancyMaxActiveBlocksPerMultiprocessor(&per_cu, fwd_megakernel, 512, LDS_BYTES);
        if (per_cu < 1) per_cu = 1;
        grid_blocks = cus * per_cu;
        if (grid_blocks > 256) grid_blocks = 256;
    }
    Params p{};
    for (int i = 0; i < 21; ++i) p.in[i] = (const float*)d_in[i];
    p.out = (float*)d_out; p.ws = (char*)d_ws;
    if (ws_size < WS_NEED) { fprintf(stderr, "workspace too small: %zu < %zu\n", ws_size, (size_t)WS_NEED); }
    hipMemsetAsync((char*)d_ws + OFF_BAR, 0, 16384, stream);
#if MK_MULTI
    for (int s = 0; s < NSTEPS; ++s) { int s0 = s, s1 = s + 1; hipLaunchKernelGGL(fwd_megakernel, dim3(grid_blocks), dim3(512), LDS_BYTES, stream, p, s0, s1); }
#else
    int s0 = 0, s1 = NSTEPS;
    void* args[] = {&p, &s0, &s1};
    hipError_t e = hipLaunchCooperativeKernel((const void*)fwd_megakernel, dim3(grid_blocks), dim3(512), args, LDS_BYTES, stream);
    if (e != hipSuccess) fprintf(stderr, "cooperative launch failed: %s (grid %d)\n", hipGetErrorString(e), grid_blocks);
#endif
}
```
